# Optimizing an MI355X kernel written in HIP

```python
import jax, jax.numpy as jnp
from jax import lax
import numpy as np

D_MODEL = 1024
BATCH = 8
SEQ = 8192
DEPTH = 1

N_META = 16
D_RNN = D_MODEL
N_RNN_BLOCKS = 4
RNN_BLOCK = D_RNN // N_RNN_BLOCKS
CONV_WIDTH = 4
LRU_C = 8.0
POOL_WINDOWS = (2, 4, 8, 16)
N_POOL_GROUPS = len(POOL_WINDOWS)
D_POOL = D_MODEL // 2
POOL_GROUP = D_POOL // N_POOL_GROUPS
N_BRANCH = 2
D_IN_PROJ = 2 * D_RNN + D_POOL + N_BRANCH * D_MODEL
PEER_HEADS = 8
PEER_NKEYS = 128
N_EXPERTS = PEER_NKEYS * PEER_NKEYS
PEER_DK = 256
PEER_HALF = PEER_DK // 2
PEER_TOPK = 16
PEER_TOKENS_PER_STEP = 256
ALPHA = (2.0 * DEPTH) ** 0.25
BETA = (8.0 * DEPTH) ** -0.25
LN_EPS = 1e-5

kernel_name = "hybrid_rglru_pool_peer_deepnorm"


def layer_norm(x, g, b):
    xf = x.astype(jnp.float32)
    mu = jnp.mean(xf, axis=-1, keepdims=True)
    xc = xf - mu
    var = jnp.mean(jnp.square(xc), axis=-1, keepdims=True)
    return xc * lax.rsqrt(var + LN_EPS) * g.astype(jnp.float32) + b.astype(jnp.float32)


def _lru_combine(earlier, later):
    a1, b1 = earlier
    a2, b2 = later
    return a1 * a2, a2 * b1 + b2


def rglru_branch(xr, gate, conv_w, conv_b, w_rg, b_rg, w_ig, b_ig, lru_L):
    B, T, _ = xr.shape
    xc = lax.conv_general_dilated(
        xr.astype(jnp.float32), conv_w.astype(jnp.float32)[:, None, :],
        window_strides=(1,), padding=[(CONV_WIDTH - 1, 0)],
        dimension_numbers=("NWC", "WIO", "NWC"), feature_group_count=D_RNN,
    ) + conv_b
    xb = xc.reshape(B, T, N_RNN_BLOCKS, RNN_BLOCK)
    r = jax.nn.sigmoid(jnp.einsum("btnc,ncd->btnd", xb, w_rg) + b_rg).reshape(B, T, D_RNN)
    i = jax.nn.sigmoid(jnp.einsum("btnc,ncd->btnd", xb, w_ig) + b_ig).reshape(B, T, D_RNN)
    log_a = LRU_C * r * jax.nn.log_sigmoid(lru_L.astype(jnp.float32))
    a = jnp.exp(log_a)
    mult = jnp.sqrt(-jnp.expm1(2.0 * log_a))
    _, h = lax.associative_scan(_lru_combine, (a, mult * i * xc), axis=1)
    return h * jax.nn.gelu(gate.astype(jnp.float32))


def pool_branch(xp, pool_w, pool_scale):
    B, T, _ = xp.shape
    xf = xp.astype(jnp.float32)
    c = jnp.cumsum(xf, axis=1)
    count = jnp.arange(1, T + 1, dtype=jnp.float32)[None, :, None]
    means = []
    for g, w in enumerate(POOL_WINDOWS):
        cg = c[..., g * POOL_GROUP:(g + 1) * POOL_GROUP]
        lag = jnp.pad(cg[:, :-w], ((0, 0), (w, 0), (0, 0)))
        means.append((cg - lag) / jnp.minimum(count, float(w)))
    pooled = jnp.concatenate(means, axis=-1) - xf
    mixed = jnp.einsum("btgc,gcd->btgd", pooled.reshape(B, T, N_POOL_GROUPS, POOL_GROUP), pool_w)
    return mixed.reshape(B, T, D_POOL) * pool_scale


def peer_retrieve(h, w_q, sub_keys):
    N = h.shape[0]
    q = jnp.einsum("nd,de->ne", h, w_q).reshape(N, PEER_HEADS, 2, PEER_HALF)
    s = jnp.einsum("nhpd,hpkd->nhpk", q, sub_keys).astype(jnp.float32)
    sv, si = lax.top_k(s, PEER_TOPK)
    comb = (sv[:, :, 0, :, None] + sv[:, :, 1, None, :]).reshape(N, PEER_HEADS, PEER_TOPK * PEER_TOPK)
    cv, ci = lax.top_k(comb, PEER_TOPK)
    k1 = jnp.take_along_axis(si[:, :, 0], ci // PEER_TOPK, axis=-1)
    k2 = jnp.take_along_axis(si[:, :, 1], ci % PEER_TOPK, axis=-1)
    ids = k1 * PEER_NKEYS + k2
    wts = jax.nn.softmax(cv, axis=-1)
    return ids.reshape(N, PEER_HEADS * PEER_TOPK), wts.reshape(N, PEER_HEADS * PEER_TOPK)


def peer_experts(h, ids, wts, expert_u, expert_v):
    N, D = h.shape
    n_pad = (-N) % PEER_TOKENS_PER_STEP
    hp = jnp.pad(h, ((0, n_pad), (0, 0))).reshape(-1, PEER_TOKENS_PER_STEP, D)
    ip = jnp.pad(ids, ((0, n_pad), (0, 0))).reshape(-1, PEER_TOKENS_PER_STEP, ids.shape[1])
    wp = jnp.pad(wts, ((0, n_pad), (0, 0))).reshape(-1, PEER_TOKENS_PER_STEP, wts.shape[1])

    def step(args):
        hc, ic, wc = args
        u = expert_u[ic]
        z = jax.nn.gelu(jnp.einsum("cd,ced->ce", hc, u).astype(jnp.float32))
        v = expert_v[ic]
        return jnp.einsum("ce,ced->cd", wc * z, v).astype(jnp.float32)

    out = lax.map(step, (hp, ip, wp))
    return out.reshape(-1, D)[:N]


def setup_inputs(seed: int = 0) -> dict:
    key = jax.random.key(seed)
    ks = jax.random.split(key, 26)
    f32 = jnp.float32
    nrm = lambda k, shape, scale: jax.random.normal(k, shape, f32) * scale
    L = DEPTH
    u_a = jax.random.uniform(ks[11], (L, D_RNN), f32, minval=0.9, maxval=0.999)
    a_base = u_a ** (1.0 / LRU_C)
    return {
        "x": nrm(ks[0], (BATCH, SEQ, D_MODEL), 1.0),
        "meta": nrm(ks[1], (N_META, D_MODEL), 1.0),
        "ln_in_g": 1.0 + nrm(ks[2], (D_MODEL,), 0.02),
        "ln_in_b": nrm(ks[3], (D_MODEL,), 0.02),
        "w_in": nrm(ks[4], (L, D_MODEL, D_IN_PROJ), D_MODEL ** -0.5),
        "conv_w": nrm(ks[5], (L, CONV_WIDTH, D_RNN), CONV_WIDTH ** -0.5),
        "conv_b": nrm(ks[6], (L, D_RNN), 0.01),
        "w_rg": nrm(ks[7], (L, N_RNN_BLOCKS, RNN_BLOCK, RNN_BLOCK), RNN_BLOCK ** -0.5),
        "b_rg": nrm(ks[8], (L, N_RNN_BLOCKS, RNN_BLOCK), 0.01),
        "w_ig": nrm(ks[9], (L, N_RNN_BLOCKS, RNN_BLOCK, RNN_BLOCK), RNN_BLOCK ** -0.5),
        "b_ig": nrm(ks[10], (L, N_RNN_BLOCKS, RNN_BLOCK), 0.01),
        "lru_L": jnp.log(a_base) - jnp.log1p(-a_base),
        "w_proj_a": nrm(ks[12], (L, D_RNN, D_MODEL), D_RNN ** -0.5),
        "pool_w": nrm(ks[13], (L, N_POOL_GROUPS, POOL_GROUP, POOL_GROUP), POOL_GROUP ** -0.5),
        "pool_scale": 1.0 + nrm(ks[14], (L, D_POOL), 0.02),
        "w_proj_b": nrm(ks[15], (L, D_POOL, D_MODEL), D_POOL ** -0.5),
        "w_out": nrm(ks[16], (L, D_MODEL, D_MODEL), BETA * D_MODEL ** -0.5),
        "ln1_g": 1.0 + nrm(ks[17], (L, D_MODEL), 0.02),
        "ln1_b": nrm(ks[18], (L, D_MODEL), 0.02),
        "w_q": nrm(ks[19], (L, D_MODEL, PEER_HEADS * PEER_DK), D_MODEL ** -0.5),
        "sub_keys": nrm(ks[20], (L, PEER_HEADS, 2, PEER_NKEYS, PEER_HALF), PEER_HALF ** -0.5),
        "expert_u": nrm(ks[21], (L, N_EXPERTS, D_MODEL), D_MODEL ** -0.5),
        "expert_v": nrm(ks[22], (L, N_EXPERTS, D_MODEL), BETA),
        "ln2_g": 1.0 + nrm(ks[23], (L, D_MODEL), 0.02),
        "ln2_b": nrm(ks[24], (L, D_MODEL), 0.02),
    }


def reference(x, meta, ln_in_g, ln_in_b, w_in, conv_w, conv_b, w_rg, b_rg, w_ig, b_ig, lru_L,
              w_proj_a, pool_w, pool_scale, w_proj_b, w_out, ln1_g, ln1_b, w_q, sub_keys,
              expert_u, expert_v, ln2_g, ln2_b):
    B = x.shape[0]
    meta_b = jnp.broadcast_to(meta[None].astype(x.dtype), (B, N_META, D_MODEL))
    h = layer_norm(jnp.concatenate([meta_b, x], axis=1), ln_in_g, ln_in_b)
    T = h.shape[1]
    for l in range(DEPTH):
        proj = jnp.einsum("btd,de->bte", h, w_in[l])
        xr = proj[..., :D_RNN]
        gate_r = proj[..., D_RNN:2 * D_RNN]
        xp = proj[..., 2 * D_RNN:2 * D_RNN + D_POOL]
        g_logits = proj[..., 2 * D_RNN + D_POOL:]
        y_a = jnp.einsum("bte,ed->btd",
                         rglru_branch(xr, gate_r, conv_w[l], conv_b[l], w_rg[l], b_rg[l],
                                      w_ig[l], b_ig[l], lru_L[l]), w_proj_a[l])
        y_b = jnp.einsum("bte,ed->btd", pool_branch(xp, pool_w[l], pool_scale[l]), w_proj_b[l])
        gates = jax.nn.sigmoid(g_logits.astype(jnp.float32))
        merged = gates[..., :D_MODEL] * y_a + gates[..., D_MODEL:] * y_b
        mix_out = jnp.einsum("btd,de->bte", merged, w_out[l])
        h = layer_norm(ALPHA * h + mix_out, ln1_g[l], ln1_b[l])
        hf = h.reshape(B * T, D_MODEL)
        ids, wts = peer_retrieve(hf, w_q[l], sub_keys[l])
        ffn = peer_experts(hf, ids, wts, expert_u[l], expert_v[l]).reshape(B, T, D_MODEL)
        h = layer_norm(ALPHA * h + ffn, ln2_g[l], ln2_b[l])
    return h[:, N_META:].astype(x.dtype)
```

```cpp
#include <hip/hip_runtime.h>
#include <hip/hip_cooperative_groups.h>
#include <cstdio>
#include <cstdint>
namespace cg = cooperative_groups;

#ifndef MK_ONE_LAUNCH
#define MK_ONE_LAUNCH 1
#endif

#define LAS __attribute__((address_space(3)))
typedef unsigned short bf16;
typedef unsigned u32x4 __attribute__((ext_vector_type(4)));
typedef unsigned u32x2 __attribute__((ext_vector_type(2)));
typedef float f32x4 __attribute__((ext_vector_type(4)));
typedef float f32x2 __attribute__((ext_vector_type(2)));
typedef short bf16x8 __attribute__((ext_vector_type(8)));

constexpr int NB = 8, SEQ = 8192, D = 1024, M = NB * SEQ, NMETA = 16, NPROJ = 4608, DPOOL = 512;
constexpr int PH = 8, PKEYS = 128, NSEL = 128;
constexpr float ALPHA = 1.189207115002721f, LN_EPS = 1e-5f, LOG2E = 1.4426950408889634f;
constexpr int NWAVES = 8, NTHREADS = 512;
constexpr int LDS_BYTES = 147456;

constexpr size_t MiB = 1u << 20;
constexpr size_t WS_CTL = 0;
constexpr size_t WS_PROJM = 1 * MiB;
constexpr size_t WS_HMETA = 1 * MiB + 128 * 1024;
constexpr size_t WS_LS8 = 1 * MiB + 192 * 1024;
constexpr size_t WS_AGG = 2 * MiB;
constexpr size_t WS_SUBAGG = 4 * MiB;
constexpr size_t WS_WCOMBF = 12 * MiB;
constexpr size_t WS_KEYS = 14 * MiB;
constexpr size_t WS_GATET = 15 * MiB;
constexpr size_t WS_WINT = 16 * MiB;
constexpr size_t WS_BCAT = 25 * MiB;
constexpr size_t WS_WOUTT = 28 * MiB;
constexpr size_t WS_WQT = 30 * MiB;
constexpr size_t WS_H0 = 34 * MiB;
constexpr size_t WS_ACAT = 162 * MiB;
constexpr int ACAT_LD = 1536;
constexpr size_t WS_H1 = WS_ACAT;
constexpr size_t WS_GL = 354 * MiB;
constexpr size_t WS_V1 = WS_GL;
constexpr size_t WS_FFN = WS_GL + 128 * MiB;
constexpr size_t WS_XC = 610 * MiB;
constexpr size_t WS_XR = 738 * MiB;
constexpr size_t WS_LOGA = WS_XR;
constexpr size_t WS_MERGED = WS_XR;
constexpr size_t WS_XP = 866 * MiB;
constexpr size_t WS_BB = WS_XP;
constexpr size_t WS_Q = 546 * MiB;
constexpr size_t WS_IDW = 802 * MiB;
constexpr size_t WS_U8 = 866 * MiB;
constexpr size_t WS_V8 = 882 * MiB;
constexpr size_t WS_H8 = 898 * MiB;
constexpr size_t WS_ZI = 962 * MiB;
constexpr size_t WS_SU = 994 * MiB;
constexpr size_t WS_SH = 994 * MiB + 131072;
constexpr size_t WS_H0Q = 610 * MiB;
constexpr size_t WS_SA = 995 * MiB;
constexpr size_t WS_WG8 = 996 * MiB;
constexpr size_t WS_SB = 1001 * MiB;
constexpr size_t WS_WQ8 = 1002 * MiB;
constexpr size_t WS_SQ = 1004 * MiB;
constexpr size_t WS_END = 1024 * MiB;

typedef __bf16 bf16x2_cv __attribute__((ext_vector_type(2)));
__device__ __forceinline__ unsigned cvt_pk_bf16(float lo, float hi) { const f32x2 v = {lo, hi}; return __builtin_bit_cast(unsigned, __builtin_convertvector(v, bf16x2_cv)); }
__device__ __forceinline__ float bf_lo(unsigned u) { return __uint_as_float(u << 16); }
__device__ __forceinline__ float bf_hi(unsigned u) { return __uint_as_float(u & 0xffff0000u); }
__device__ __forceinline__ float fast_exp(float x) { return __builtin_amdgcn_exp2f(x * LOG2E); }
__device__ __forceinline__ float sigmoidf_(float x) { return __builtin_amdgcn_rcpf(1.f + fast_exp(-x)); }
__device__ __forceinline__ float gelu_tanh(float x) { const float u2 = 1.5957691216057308f * x * (1.f + 0.044715f * x * x); return x * __builtin_amdgcn_rcpf(1.f + fast_exp(-u2)); }
template <int CTRL> __device__ __forceinline__ float dpp_f(float v) { return __builtin_bit_cast(float, __builtin_amdgcn_update_dpp(0, __builtin_bit_cast(int, v), CTRL, 0xf, 0xf, true)); }
__device__ __forceinline__ float wave_sum(float v) {
    v += dpp_f<0xB1>(v); v += dpp_f<0x4E>(v); v += dpp_f<0x141>(v); v += dpp_f<0x140>(v);
    { auto q = __builtin_amdgcn_permlane16_swap(__float_as_uint(v), __float_as_uint(v), false, false); v = __uint_as_float(q[0]) + __uint_as_float(q[1]); }
    { auto q = __builtin_amdgcn_permlane32_swap(__float_as_uint(v), __float_as_uint(v), false, false); v = __uint_as_float(q[0]) + __uint_as_float(q[1]); }
    return v; }
__device__ __forceinline__ float wave_max(float v) {
    v = fmaxf(v, dpp_f<0xB1>(v)); v = fmaxf(v, dpp_f<0x4E>(v)); v = fmaxf(v, dpp_f<0x141>(v)); v = fmaxf(v, dpp_f<0x140>(v));
    { auto q = __builtin_amdgcn_permlane16_swap(__float_as_uint(v), __float_as_uint(v), false, false); v = fmaxf(__uint_as_float(q[0]), __uint_as_float(q[1])); }
    { auto q = __builtin_amdgcn_permlane32_swap(__float_as_uint(v), __float_as_uint(v), false, false); v = fmaxf(__uint_as_float(q[0]), __uint_as_float(q[1])); }
    return v; }
__device__ __forceinline__ int wave_min_i(int v) {
#pragma unroll
    for (int o = 1; o < 64; o <<= 1) v = min(v, __shfl_xor(v, o));
    return v; }
__device__ __forceinline__ float wave_sum_u(float v) {
    v += dpp_f<0xB1>(v); v += dpp_f<0x4E>(v); v += dpp_f<0x141>(v); v += dpp_f<0x140>(v);
    return (__builtin_bit_cast(float, __builtin_amdgcn_readlane(__builtin_bit_cast(int, v), 0)) + __builtin_bit_cast(float, __builtin_amdgcn_readlane(__builtin_bit_cast(int, v), 16))) +
           (__builtin_bit_cast(float, __builtin_amdgcn_readlane(__builtin_bit_cast(int, v), 32)) + __builtin_bit_cast(float, __builtin_amdgcn_readlane(__builtin_bit_cast(int, v), 48))); }
typedef __bf16 bf16x2_t __attribute__((ext_vector_type(2)));
__device__ __forceinline__ float dot2bf(unsigned a, unsigned b, float c) { return __builtin_amdgcn_fdot2_f32_bf16(__builtin_bit_cast(bf16x2_t, a), __builtin_bit_cast(bf16x2_t, b), c, false); }
__device__ __forceinline__ float dot8bf(const u32x4 a, const u32x4 b, float c) { c = dot2bf(a.x, b.x, c); c = dot2bf(a.y, b.y, c); c = dot2bf(a.z, b.z, c); return dot2bf(a.w, b.w, c); }
#define LDS_WAIT() asm volatile("s_waitcnt lgkmcnt(0)" ::: "memory")
__device__ __forceinline__ void unpack8(const u32x4 w, float (&f)[8]) {
    f[0] = bf_lo(w.x); f[1] = bf_hi(w.x); f[2] = bf_lo(w.y); f[3] = bf_hi(w.y); f[4] = bf_lo(w.z); f[5] = bf_hi(w.z); f[6] = bf_lo(w.w); f[7] = bf_hi(w.w); }
__device__ __forceinline__ u32x4 pack8(const float (&f)[8]) { u32x4 w; w.x = cvt_pk_bf16(f[0], f[1]); w.y = cvt_pk_bf16(f[2], f[3]); w.z = cvt_pk_bf16(f[4], f[5]); w.w = cvt_pk_bf16(f[6], f[7]); return w; }

namespace pg8 {
constexpr int BM = 256, BK = 64, HALF = 128, HTB = HALF * BK * 2, STAGE_BYTES = 8 * HTB, NXCD = 8, WGM = 8;
__host__ __device__ __forceinline__ int lds_byte(int r, int c) { const int st = (r >> 4) * 2 + (c >> 5), rr = r & 15, cc = c & 31, ob = rr * 64 + cc * 2; return st * 1024 + (ob ^ (((ob >> 9) & 1) << 5)); }
__host__ __device__ __forceinline__ void stage_rc(int b, int& R, int& C) { const int st = b / 1024, sb = b % 1024, swz = sb ^ (((sb >> 9) & 1) << 5); R = (st >> 1) * 16 + swz / 64; C = (st & 1) * 32 + (swz % 64) / 2; }
__host__ __device__ __forceinline__ int perm32(int rho) { const int n = rho >> 4, i = rho & 15; return 8 * (i >> 2) + 4 * n + (i & 3); }

struct Unit { int pm, pn; };
struct Gemm { const char* A; const char* B; unsigned lda, ldb; int nt, nM, nN, a_shift; int b_gap_at = 1 << 30, b_gap_rows = 0; };
__device__ __forceinline__ const char* a_tile(const Gemm& g, const Unit& u) { size_t off = (size_t)u.pm * 256 * g.lda; if (g.a_shift >= 0) off += (size_t)(u.pn >> g.a_shift) * 256; return g.A + off * 2; }
__device__ __forceinline__ const char* b_tile(const Gemm& g, const Unit& u) { return g.B + (size_t)(u.pn * 256 + (u.pn >= g.b_gap_at ? g.b_gap_rows : 0)) * g.ldb * 2; }

struct StaticOrder {
    int nM, nN, nwg, G, c;
    __device__ void init(int nM_, int nN_, int G_, int c_) { nM = nM_; nN = nN_; nwg = nM * nN; G = G_; c = c_; }
    __device__ bool next(int i, Unit& u) const {
        const long L = (long)i * G + c; if (L >= nwg) return false;
        int wgid = (int)L; { const int q = nwg / NXCD, r = nwg % NXCD, xcd = wgid % NXCD, off = wgid / NXCD; wgid = (xcd < r ? xcd * (q + 1) : r * (q + 1) + (xcd - r) * q) + off; }
        const int nig = WGM * nN, gid = wgid / nig, fm = gid * WGM, gsz = (nM - fm) < WGM ? (nM - fm) : WGM;
        u.pm = fm + ((wgid % nig) % gsz); u.pn = (wgid % nig) / gsz; return true;
    }
};

typedef int i32x4_t __attribute__((ext_vector_type(4)));
template <bool I8> __device__ __forceinline__ f32x4 mma16(const bf16x8 b, const bf16x8 a, const f32x4 c) {
    if constexpr (I8) return __builtin_bit_cast(f32x4, __builtin_amdgcn_mfma_i32_16x16x64_i8(__builtin_bit_cast(i32x4_t, b), __builtin_bit_cast(i32x4_t, a), __builtin_bit_cast(i32x4_t, c), 0, 0, 0));
    else return __builtin_amdgcn_mfma_f32_16x16x32_bf16(b, a, c, 0, 0, 0);
}
template <class Epi, bool ALIGN_EPI, bool SP2, int HOOK_T = -1, bool I8 = false>
__device__ __forceinline__ void gemm_phase(LAS unsigned char* lds, const Gemm g, const StaticOrder& S, const Epi& E) {
    const int tid = threadIdx.x, wid = __builtin_amdgcn_readfirstlane(tid >> 6), lane = tid & 63, wr = wid >> 2, wc = wid & 3, fr = lane & 15, fq = lane >> 4;
    const int nt = g.nt;
    unsigned voffA[2], voffB[2];
#pragma unroll
    for (int i = 0; i < 2; ++i) { int R, C; stage_rc(tid * 16 + i * 8192, R, C); const int Rb = (R & ~31) + perm32(R & 31);
        voffA[i] = (unsigned)(R * g.lda + C) * 2u; voffB[i] = (unsigned)(Rb * g.ldb + C) * 2u; }
    const size_t kstep = (size_t)(BK * 2);
    const size_t hstepA = (size_t)HALF * g.lda * 2, hstepB = (size_t)HALF * g.ldb * 2;
    const unsigned ldsw = (unsigned)wid * 1024u;
    const int aoff = lds_byte(wr * 64 + fr, fq * 8), boff = lds_byte(wc * 32 + fr, fq * 8);
#define PG8_SA(b, h) (((b) * 2 + (h)) * HTB)
#define PG8_SB(b, h) ((4 + (b) * 2 + (h)) * HTB)
#define PG8_STAGE(bufoff, gbase, voff) do { _Pragma("unroll") for (int _i = 0; _i < 2; ++_i) \
        __builtin_amdgcn_global_load_lds((const unsigned*)((const char*)(gbase) + (voff)[_i]), (LAS unsigned*)(lds + (bufoff) + ldsw + _i * 8192), 16, 0, 0); } while (0)
#define PG8_LDA(dst, b, h) do { _Pragma("unroll") for (int m = 0; m < 4; ++m) _Pragma("unroll") for (int k = 0; k < 2; ++k) dst[m][k] = *(const LAS bf16x8*)(lds + PG8_SA(b, h) + aoff + m * 2048 + k * 1024); } while (0)
#define PG8_LDB(dst, b, h) do { _Pragma("unroll") for (int n = 0; n < 2; ++n) _Pragma("unroll") for (int k = 0; k < 2; ++k) dst[n][k] = *(const LAS bf16x8*)(lds + PG8_SB(b, h) + boff + n * 2048 + k * 1024); } while (0)
#define PG8_MMA(ai, bj, At, Bt) do { __builtin_amdgcn_s_setprio(1); _Pragma("unroll") for (int k = 0; k < 2; ++k) _Pragma("unroll") for (int m = 0; m < 4; ++m) _Pragma("unroll") for (int n = 0; n < 2; ++n) \
        acc[ai][bj][m][n] = mma16<I8>(Bt[n][k], At[m][k], acc[ai][bj][m][n]); __builtin_amdgcn_s_setprio(0); } while (0)
#define PG8_WAIT_V(n) asm volatile("s_waitcnt vmcnt(" #n ")" ::: "memory")
#define PG8_WAIT_L(n) asm volatile("s_waitcnt lgkmcnt(" #n ")" ::: "memory")
#define PG8_BAR __builtin_amdgcn_s_barrier()
#define PG8_SCHED __builtin_amdgcn_sched_barrier(0)
    Unit cur, nxt; int ui = 0;
    if (!S.next(0, cur)) return;
    f32x4 acc[2][2][4][2];
#pragma unroll
    for (int a = 0; a < 2; ++a)
#pragma unroll
        for (int b = 0; b < 2; ++b)
#pragma unroll
            for (int m = 0; m < 4; ++m)
#pragma unroll
                for (int n = 0; n < 2; ++n) acc[a][b][m][n] = (f32x4){0.f, 0.f, 0.f, 0.f};
    bf16x8 At[4][2], B0[2][2], B1[2][2];
    const char* cA = a_tile(g, cur); const char* cB = b_tile(g, cur);
    if constexpr (SP2) {
        PG8_STAGE(PG8_SB(0, 0), cB, voffB); PG8_STAGE(PG8_SB(0, 1), cB + hstepB, voffB); PG8_STAGE(PG8_SA(0, 0), cA, voffA); PG8_STAGE(PG8_SA(0, 1), cA + hstepA, voffA);
        if (wr == 1) PG8_BAR;
        PG8_WAIT_V(2); PG8_BAR;
        PG8_STAGE(PG8_SB(1, 0), cB + kstep, voffB); PG8_STAGE(PG8_SA(1, 0), cA + kstep, voffA); PG8_STAGE(PG8_SB(1, 1), cB + hstepB + kstep, voffB);
        PG8_WAIT_V(6); PG8_BAR;
    } else {
        PG8_STAGE(PG8_SB(0, 0), cB, voffB); PG8_STAGE(PG8_SA(0, 0), cA, voffA); PG8_STAGE(PG8_SB(0, 1), cB + hstepB, voffB); PG8_STAGE(PG8_SA(0, 1), cA + hstepA, voffA);
        if (wr == 1) PG8_BAR;
        PG8_WAIT_V(4); PG8_BAR;
        PG8_STAGE(PG8_SB(1, 0), cB + kstep, voffB); PG8_STAGE(PG8_SA(1, 0), cA + kstep, voffA); PG8_STAGE(PG8_SB(1, 1), cB + hstepB + kstep, voffB);
        PG8_WAIT_V(6); PG8_BAR;
    }
    for (;;) {
        const bool has_next = S.next(ui + 1, nxt);
        const char* nA = has_next ? a_tile(g, nxt) : cA; const char* nB = has_next ? b_tile(g, nxt) : cB;
        for (int t = 0; t < nt; t += 2) {
            if constexpr (HOOK_T >= 0) { if (t == HOOK_T) E.mid(acc, cur, wr, wc, fr, fq); }
            const bool last = (t == nt - 2);
            const char* a1 = cA + (size_t)(t + 1) * kstep;
            const char* a2 = last ? nA : cA + (size_t)(t + 2) * kstep; const char* b2 = last ? nB : cB + (size_t)(t + 2) * kstep;
            const char* a3 = a2 + kstep; const char* b3 = b2 + kstep;
            if constexpr (SP2) {
            PG8_LDB(B0, 0, 0); PG8_LDB(B1, 0, 1); PG8_SCHED; PG8_LDA(At, 0, 0); PG8_STAGE(PG8_SA(1, 1), a1 + hstepA, voffA);
            PG8_WAIT_V(8); PG8_WAIT_L(0); PG8_BAR; PG8_MMA(0, 0, At, B0); PG8_MMA(0, 1, At, B1); PG8_BAR; PG8_SCHED;
            PG8_LDA(At, 0, 1); PG8_STAGE(PG8_SB(0, 0), b2, voffB); PG8_STAGE(PG8_SB(0, 1), b2 + hstepB, voffB); PG8_STAGE(PG8_SA(0, 0), a2, voffA);
            PG8_WAIT_V(8); PG8_WAIT_L(0); PG8_BAR; PG8_MMA(1, 0, At, B0); PG8_MMA(1, 1, At, B1); PG8_BAR; PG8_SCHED;
            PG8_LDB(B0, 1, 0); PG8_LDB(B1, 1, 1); PG8_SCHED; PG8_LDA(At, 1, 0); PG8_STAGE(PG8_SA(0, 1), a2 + hstepA, voffA);
            PG8_WAIT_V(8); PG8_WAIT_L(0); PG8_BAR; PG8_MMA(0, 0, At, B0); PG8_MMA(0, 1, At, B1); PG8_BAR; PG8_SCHED;
            PG8_LDA(At, 1, 1); PG8_STAGE(PG8_SB(1, 0), b3, voffB); PG8_STAGE(PG8_SB(1, 1), b3 + hstepB, voffB); PG8_STAGE(PG8_SA(1, 0), a3, voffA);
            PG8_WAIT_V(8); PG8_WAIT_L(0); PG8_BAR; PG8_MMA(1, 0, At, B0); PG8_MMA(1, 1, At, B1); PG8_BAR; PG8_SCHED;
            } else {
            PG8_LDB(B0, 0, 0); PG8_SCHED; PG8_LDA(At, 0, 0); PG8_STAGE(PG8_SA(1, 1), a1 + hstepA, voffA);
            PG8_WAIT_L(8); PG8_BAR; PG8_WAIT_L(0); PG8_MMA(0, 0, At, B0); PG8_BAR; PG8_SCHED;
            PG8_LDB(B1, 0, 1); PG8_STAGE(PG8_SB(0, 0), b2, voffB);
            PG8_BAR; PG8_WAIT_L(0); PG8_MMA(0, 1, At, B1); PG8_BAR;
            PG8_LDA(At, 0, 1); PG8_STAGE(PG8_SA(0, 0), a2, voffA);
            PG8_BAR; PG8_WAIT_L(0); PG8_MMA(1, 0, At, B0); PG8_BAR; PG8_SCHED;
            PG8_STAGE(PG8_SB(0, 1), b2 + hstepB, voffB);
            PG8_WAIT_V(6); PG8_BAR; PG8_MMA(1, 1, At, B1); PG8_BAR;
            PG8_LDB(B0, 1, 0); PG8_SCHED; PG8_LDA(At, 1, 0); PG8_STAGE(PG8_SA(0, 1), a2 + hstepA, voffA);
            PG8_WAIT_L(8); PG8_BAR; PG8_WAIT_L(0); PG8_MMA(0, 0, At, B0); PG8_BAR; PG8_SCHED;
            PG8_LDB(B1, 1, 1); PG8_STAGE(PG8_SB(1, 0), b3, voffB);
            PG8_BAR; PG8_WAIT_L(0); PG8_MMA(0, 1, At, B1); PG8_BAR;
            PG8_LDA(At, 1, 1); PG8_STAGE(PG8_SA(1, 0), a3, voffA);
            PG8_BAR; PG8_WAIT_L(0); PG8_MMA(1, 0, At, B0); PG8_BAR; PG8_SCHED;
            PG8_STAGE(PG8_SB(1, 1), b3 + hstepB, voffB);
            PG8_WAIT_V(6); PG8_BAR; PG8_MMA(1, 1, At, B1); PG8_BAR;
            }
        }
        if constexpr (ALIGN_EPI) { if (wr == 0) PG8_BAR; }
        E(acc, cur, wr, wc, fr, fq);
        if (!has_next) break;
#pragma unroll
        for (int a = 0; a < 2; ++a)
#pragma unroll
            for (int b = 0; b < 2; ++b)
#pragma unroll
                for (int m = 0; m < 4; ++m)
#pragma unroll
                    for (int n = 0; n < 2; ++n) acc[a][b][m][n] = (f32x4){0.f, 0.f, 0.f, 0.f};
        cur = nxt; cA = nA; cB = nB; ++ui;
        if constexpr (ALIGN_EPI) { if (wr == 1) PG8_BAR; }
    }
    PG8_WAIT_V(0);
    if constexpr (!ALIGN_EPI) { if (wr == 0) PG8_BAR; }
    PG8_BAR;
#undef PG8_SA
#undef PG8_SB
#undef PG8_STAGE
#undef PG8_LDA
#undef PG8_LDB
#undef PG8_MMA
#undef PG8_WAIT_V
#undef PG8_WAIT_L
#undef PG8_BAR
#undef PG8_SCHED
}

#define EPI_FOR_ROWS  _Pragma("unroll") for (int ai = 0; ai < 2; ++ai) _Pragma("unroll") for (int m = 0; m < 4; ++m)
#define EPI_ROW (u.pm * 256 + ai * 128 + wr * 64 + m * 16 + fr)
#define EPI_VALS(bj) const float v[8] = {acc[ai][bj][m][0][0], acc[ai][bj][m][0][1], acc[ai][bj][m][0][2], acc[ai][bj][m][0][3], acc[ai][bj][m][1][0], acc[ai][bj][m][1][1], acc[ai][bj][m][1][2], acc[ai][bj][m][1][3]}

struct EpiInProj {
    bf16 *XR, *XP;
    __device__ __forceinline__ void operator()(const f32x4 (&acc)[2][2][4][2], const Unit& u, int wr, int wc, int fr, int fq) const {
        bf16* base; int ld, ct;
        if (u.pn < 4) { base = XR; ld = 1024; ct = u.pn; } else { base = XP; ld = 512; ct = u.pn - 4; }
        EPI_FOR_ROWS { bf16* rowp = base + (size_t)EPI_ROW * ld + ct * 256 + wc * 32 + 8 * fq;
#pragma unroll
            for (int bj = 0; bj < 2; ++bj) { EPI_VALS(bj); *(u32x4*)(rowp + bj * 128) = pack8(v); } }
    }
};
struct EpiInProjSig {
    bf16* GL;
    __device__ __forceinline__ void operator()(const f32x4 (&acc)[2][2][4][2], const Unit& u, int wr, int wc, int fr, int fq) const {
        EPI_FOR_ROWS { bf16* rowp = GL + (size_t)EPI_ROW * 2048 + u.pn * 256 + wc * 32 + 8 * fq;
#pragma unroll
            for (int bj = 0; bj < 2; ++bj) { EPI_VALS(bj); float o[8];
#pragma unroll
                for (int e = 0; e < 8; ++e) o[e] = sigmoidf_(v[e]);
                *(u32x4*)(rowp + bj * 128) = pack8(o); } }
    }
};
struct EpiInProjSig8 {
    bf16 *XR, *ACAT, *XP, *GL; const float *SA, *SB;
    template <bool SIG> __device__ __forceinline__ void run(const f32x4 (&acc)[2][2][4][2], const Unit& u, bf16* base, int ld, int ct, const float (&sb)[2][8], int wr, int wc, int fr, int fq) const {
        EPI_FOR_ROWS { const size_t row = EPI_ROW; const float sa = SA[row]; bf16* rowp = base + row * ld + ct * 256 + wc * 32 + 8 * fq;
#pragma unroll
            for (int bj = 0; bj < 2; ++bj) { EPI_VALS(bj); float o[8];
#pragma unroll
                for (int e = 0; e < 8; ++e) { const float x = (float)__float_as_int(v[e]) * (sa * sb[bj][e]); o[e] = SIG ? sigmoidf_(x) : x; }
                *(u32x4*)(rowp + bj * 128) = pack8(o); } }
    }
    __device__ __forceinline__ void operator()(const f32x4 (&acc)[2][2][4][2], const Unit& u, int wr, int wc, int fr, int fq) const {
        float sb[2][8];
#pragma unroll
        for (int bj = 0; bj < 2; ++bj)
#pragma unroll
            for (int e = 0; e < 8; ++e) sb[bj][e] = SB[u.pn * 256 + bj * 128 + wc * 32 + 8 * fq + e];
        if (u.pn >= 10) run<true>(acc, u, GL, 2048, u.pn - 10, sb, wr, wc, fr, fq);
        else if (u.pn < 4) run<false>(acc, u, XR, 1024, u.pn, sb, wr, wc, fr, fq);
        else if (u.pn < 8) run<false>(acc, u, ACAT + 512, ACAT_LD, u.pn - 4, sb, wr, wc, fr, fq);
        else run<false>(acc, u, XP, 512, u.pn - 8, sb, wr, wc, fr, fq);
    }
};
struct EpiQ8 {
    bf16* Q; const float *SH, *SQ;
    __device__ __forceinline__ void operator()(const f32x4 (&acc)[2][2][4][2], const Unit& u, int wr, int wc, int fr, int fq) const {
        float sq[2][8];
#pragma unroll
        for (int bj = 0; bj < 2; ++bj)
#pragma unroll
            for (int e = 0; e < 8; ++e) sq[bj][e] = SQ[u.pn * 256 + bj * 128 + wc * 32 + 8 * fq + e];
        EPI_FOR_ROWS { const size_t row = EPI_ROW; const float sa = SH[row]; bf16* rowp = Q + row * 2048 + u.pn * 256 + wc * 32 + 8 * fq;
#pragma unroll
            for (int bj = 0; bj < 2; ++bj) { EPI_VALS(bj); float o[8];
#pragma unroll
                for (int e = 0; e < 8; ++e) o[e] = (float)__float_as_int(v[e]) * (sa * sq[bj][e]);
                *(u32x4*)(rowp + bj * 128) = pack8(o); } }
    }
};
struct EpiGate {
    const bf16* XC; const float *b_rg, *b_ig, *LS8; bf16 *LOGA, *BB;
    __device__ __forceinline__ void operator()(const f32x4 (&acc)[2][2][4][2], const Unit& u, int wr, int wc, int fr, int fq) const {
        const int c0 = (u.pn >> 1) * 256 + (u.pn & 1) * 128 + wc * 32 + 8 * fq;
#pragma unroll
        for (int ai = 0; ai < 2; ++ai) {
            u32x4 xw4[4];
#pragma unroll
            for (int m = 0; m < 4; ++m) xw4[m] = *(const u32x4*)(XC + (size_t)EPI_ROW * 1024 + c0);
#pragma unroll
            for (int m = 0; m < 4; ++m) { const size_t off = (size_t)EPI_ROW * 1024 + c0; const u32x4 xw = xw4[m]; u32x4 ow_l, ow_b;
#pragma unroll
                for (int n = 0; n < 2; ++n) {
                    const f32x4 br = *(const f32x4*)(b_rg + c0 + 4 * n), bi = *(const f32x4*)(b_ig + c0 + 4 * n), ls = *(const f32x4*)(LS8 + c0 + 4 * n);
                    const unsigned x01 = n ? xw.z : xw.x, x23 = n ? xw.w : xw.y;
                    const float xc[4] = {bf_lo(x01), bf_hi(x01), bf_lo(x23), bf_hi(x23)};
                    float la[4], bb[4];
#pragma unroll
                    for (int e = 0; e < 4; ++e) { const float rl = acc[ai][0][m][n][e] + br[e], il = acc[ai][1][m][n][e] + bi[e];
                        const float r = sigmoidf_(rl), ig = sigmoidf_(il); const float l = ls[e] * r; const float t2 = 2.f * l;
                        const float em = (t2 > -0.02f) ? -(t2 * (1.f + t2 * (0.5f + t2 * (1.f / 6.f)))) : (1.f - fast_exp(t2));
                        la[e] = l; bb[e] = sqrtf(em) * ig * xc[e]; }
                    if (n == 0) { ow_l.x = cvt_pk_bf16(la[0], la[1]); ow_l.y = cvt_pk_bf16(la[2], la[3]); ow_b.x = cvt_pk_bf16(bb[0], bb[1]); ow_b.y = cvt_pk_bf16(bb[2], bb[3]); }
                    else { ow_l.z = cvt_pk_bf16(la[0], la[1]); ow_l.w = cvt_pk_bf16(la[2], la[3]); ow_b.z = cvt_pk_bf16(bb[0], bb[1]); ow_b.w = cvt_pk_bf16(bb[2], bb[3]); } }
                *(u32x4*)(LOGA + off) = ow_l; *(u32x4*)(BB + off) = ow_b; }
            asm volatile("" ::: "memory"); }
    }
};
struct EpiMerge {
    const bf16* GL; bf16* MERGED;
    __device__ __forceinline__ void mid(f32x4 (&acc)[2][2][4][2], const Unit& u, int wr, int wc, int fr, int fq) const {
        EPI_FOR_ROWS { const size_t row = EPI_ROW;
#pragma unroll
            for (int bj = 0; bj < 2; ++bj) { const int c0 = u.pn * 256 + bj * 128 + wc * 32 + 8 * fq;
                float ga[8], gb[8]; unpack8(*(const u32x4*)(GL + row * 2048 + c0), ga); unpack8(*(const u32x4*)(GL + row * 2048 + 1024 + c0), gb);
#pragma unroll
                for (int e = 0; e < 8; ++e) acc[ai][bj][m][e >> 2][e & 3] *= gb[e] * __builtin_amdgcn_rcpf(fmaxf(ga[e], 1e-12f)); }
            if (m & 1) asm volatile("" ::: "memory"); }
    }
    __device__ __forceinline__ void operator()(const f32x4 (&acc)[2][2][4][2], const Unit& u, int wr, int wc, int fr, int fq) const {
        EPI_FOR_ROWS { const size_t row = EPI_ROW;
#pragma unroll
            for (int bj = 0; bj < 2; ++bj) { const int c0 = u.pn * 256 + bj * 128 + wc * 32 + 8 * fq; EPI_VALS(bj);
                float ga[8], o[8]; unpack8(*(const u32x4*)(GL + row * 2048 + c0), ga);
#pragma unroll
                for (int e = 0; e < 8; ++e) o[e] = fmaxf(ga[e], 1e-12f) * v[e];
                *(u32x4*)(MERGED + row * 1024 + c0) = pack8(o); } }
    }
};
struct EpiOut {
    const bf16* H0; bf16* V1;
    __device__ __forceinline__ void operator()(const f32x4 (&acc)[2][2][4][2], const Unit& u, int wr, int wc, int fr, int fq) const {
        EPI_FOR_ROWS { const size_t row = EPI_ROW;
#pragma unroll
            for (int bj = 0; bj < 2; ++bj) { const int c0 = u.pn * 256 + bj * 128 + wc * 32 + 8 * fq; EPI_VALS(bj);
                float h[8], o[8]; unpack8(*(const u32x4*)(H0 + row * 1024 + c0), h);
#pragma unroll
                for (int e = 0; e < 8; ++e) o[e] = ALPHA * h[e] + v[e];
                *(u32x4*)(V1 + row * 1024 + c0) = pack8(o); } }
    }
};
struct EpiBf16 {
    bf16* O; int ld;
    __device__ __forceinline__ void operator()(const f32x4 (&acc)[2][2][4][2], const Unit& u, int wr, int wc, int fr, int fq) const {
        EPI_FOR_ROWS { bf16* rowp = O + (size_t)EPI_ROW * ld + u.pn * 256 + wc * 32 + 8 * fq;
#pragma unroll
            for (int bj = 0; bj < 2; ++bj) { EPI_VALS(bj); *(u32x4*)(rowp + bj * 128) = pack8(v); } }
    }
};
}

#define XB_TMO      128
#define XB_XCNT(j)  (256  + 64 * (j))
#define XB_XSUB(j)  (1280 + 64 * (j))
#define XB_XGEN(j)  (2304 + 64 * (j))
#define XB_TOP      3328
#define XB_TOPGEN   3392
#define XCD_BAR_WORDS 3456
#define XB_SPIN_CAP (1u << 18)
__device__ __forceinline__ unsigned xb_ld(unsigned* p)              { return __hip_atomic_load(p, __ATOMIC_RELAXED, __HIP_MEMORY_SCOPE_AGENT); }
__device__ __forceinline__ unsigned xb_add(unsigned* p, unsigned v) { return __hip_atomic_fetch_add(p, v, __ATOMIC_RELAXED, __HIP_MEMORY_SCOPE_AGENT); }
__device__ __forceinline__ unsigned xb_xcc_id() { return (unsigned)__builtin_amdgcn_s_getreg((3 << 11) | 20) & 0xFu; }
#define XB_SPIN(cond, bar) do { unsigned _sp = 0; while (cond) { __builtin_amdgcn_s_sleep(1); \
    if ((++_sp & 255u) == 0u) { if (xb_ld(&(bar)[XB_TMO])) break; if (_sp > XB_SPIN_CAP) { atomicAdd(&(bar)[XB_TMO], 1u); break; } } } } while (0)
struct XcdBarrier { unsigned* bar; unsigned x; volatile LAS unsigned* st; };
__device__ __forceinline__ XcdBarrier xcd_barrier_post(unsigned* bar, volatile LAS unsigned* st) {
    XcdBarrier b; b.bar = bar; b.x = xb_xcc_id(); b.st = st;
    if (threadIdx.x == 0) (void)xb_add(&bar[XB_XCNT(b.x)], 1u);
    return b;
}
__device__ __forceinline__ void xcd_barrier_complete(unsigned* bar, unsigned x, unsigned& nloc, unsigned& nx) {
    const unsigned G = gridDim.x * gridDim.y * gridDim.z;
    unsigned sum, cnt, mine, sp = 0u;
    for (;;) {
        sum = 0u; cnt = 0u; mine = 0u;
#pragma unroll
        for (unsigned j = 0; j < 16; ++j) { const unsigned c = xb_ld(&bar[XB_XCNT(j)]); sum += c; cnt += (c > 0u) ? 1u : 0u; mine = (j == x) ? c : mine; }
        if (sum == G) break;
        __builtin_amdgcn_s_sleep(1);
        if ((++sp & 255u) == 0u) { if (xb_ld(&bar[XB_TMO])) break; if (sp > XB_SPIN_CAP) { atomicAdd(&bar[XB_TMO], 1u); break; } }
    }
    nloc = mine > 0u ? mine : 1u; nx = cnt > 0u ? cnt : 1u;
}
__device__ __forceinline__ void xcd_barrier(const XcdBarrier& b) {
    asm volatile("s_waitcnt vmcnt(0)" ::: "memory");
    __syncthreads();
    if (threadIdx.x == 0) {
        unsigned* bar = b.bar;
        __builtin_amdgcn_s_waitcnt(0);
        unsigned nloc = b.st[0], nx = b.st[1];
        if (nloc == 0u) { xcd_barrier_complete(bar, b.x, nloc, nx); b.st[0] = nloc; b.st[1] = nx; }
        const unsigned old = xb_add(&bar[XB_XSUB(b.x)], 1u);
        const unsigned gen = old / nloc;
        if (old + 1u == (gen + 1u) * nloc) {
            __builtin_amdgcn_fence(__ATOMIC_RELEASE, "agent");
            asm volatile("s_waitcnt vmcnt(0)" ::: "memory");
            const unsigned og = xb_add(&bar[XB_TOP], 1u);
            const unsigned tg = og / nx;
            if (og + 1u == (tg + 1u) * nx) xb_add(&bar[XB_TOPGEN], 1u);
            else XB_SPIN(xb_ld(&bar[XB_TOPGEN]) == tg, bar);
            __builtin_amdgcn_fence(__ATOMIC_ACQUIRE, "agent");
            xb_add(&bar[XB_XGEN(b.x)], 1u);
            asm volatile("s_waitcnt vmcnt(0)" ::: "memory");
        } else {
            XB_SPIN(xb_ld(&bar[XB_XGEN(b.x)]) == gen, bar);
            __builtin_amdgcn_fence(__ATOMIC_ACQUIRE, "agent");
            asm volatile("s_waitcnt vmcnt(0)" ::: "memory");
        }
    }
    __syncthreads();
}

struct Args { const float* in[25]; float* out; unsigned char* ws; int ph_lo, ph_hi; };
enum { I_X = 0, I_META, I_LNIG, I_LNIB, I_WIN, I_CONVW, I_CONVB, I_WRG, I_BRG, I_WIG, I_BIG, I_LRUL, I_WPA, I_POOLW, I_POOLS, I_WPB, I_WOUT, I_LN1G, I_LN1B, I_WQ, I_KEYS, I_EU, I_EV, I_LN2G, I_LN2B };
constexpr int NPHASES = 14;

struct Frame { LAS unsigned char* lds; int tid, lane, wave, G, gw, NGW; };

__device__ __forceinline__ void transpose_item(const float* src, int lds_, bf16* dst, int ldt, LAS float* scr, int lane) {
#pragma unroll 8
    for (int i = 0; i < 32; ++i) { const int kk = 2 * i + (lane >> 5); scr[kk * 33 + (lane & 31)] = src[(size_t)kk * lds_ + (lane & 31)]; }
    LDS_WAIT();
    const int c = lane & 7;
#pragma unroll
    for (int j = 0; j < 4; ++j) { const int n = (lane >> 3) + 8 * j; const LAS float* s = scr + (8 * c) * 33 + n;
        u32x4 o; o.x = cvt_pk_bf16(s[0 * 33], s[1 * 33]); o.y = cvt_pk_bf16(s[2 * 33], s[3 * 33]); o.z = cvt_pk_bf16(s[4 * 33], s[5 * 33]); o.w = cvt_pk_bf16(s[6 * 33], s[7 * 33]);
        *(u32x4*)(dst + (size_t)n * ldt + 8 * c) = o; }
    LDS_WAIT();
}
__device__ __forceinline__ unsigned pack_i8x4(const f32x4 v, float inv) {
    unsigned p = 0u;
    p = __builtin_amdgcn_cvt_pk_u8_f32(__builtin_rintf(v.x * inv) + 128.f, 0u, p); p = __builtin_amdgcn_cvt_pk_u8_f32(__builtin_rintf(v.y * inv) + 128.f, 1u, p);
    p = __builtin_amdgcn_cvt_pk_u8_f32(__builtin_rintf(v.z * inv) + 128.f, 2u, p); p = __builtin_amdgcn_cvt_pk_u8_f32(__builtin_rintf(v.w * inv) + 128.f, 3u, p);
    return p ^ 0x80808080u; }
__device__ __forceinline__ float absmax4(const f32x4 (&v)[4]) { float m = 0.f;
#pragma unroll
    for (int j = 0; j < 4; ++j) m = fmaxf(fmaxf(m, fmaxf(fabsf(v[j].x), fabsf(v[j].y))), fmaxf(fabsf(v[j].z), fabsf(v[j].w)));
    return wave_max(m); }
__device__ __forceinline__ void ln_row(const float* xrow, const float* g, const float* b, int lane, f32x4 (&v)[4]) {
    float s = 0.f;
#pragma unroll
    for (int j = 0; j < 4; ++j) { v[j] = *((const f32x4*)xrow + lane + 64 * j); s += (v[j].x + v[j].y) + (v[j].z + v[j].w); }
    const float mean = wave_sum(s) * (1.f / D); float s2 = 0.f;
#pragma unroll
    for (int j = 0; j < 4; ++j) { v[j] = v[j] - mean; s2 += (v[j].x * v[j].x + v[j].y * v[j].y) + (v[j].z * v[j].z + v[j].w * v[j].w); }
    const float rstd = 1.f / sqrtf(wave_sum(s2) * (1.f / D) + LN_EPS);
#pragma unroll
    for (int j = 0; j < 4; ++j) { const f32x4 gg = *((const f32x4*)g + lane + 64 * j), bb = *((const f32x4*)b + lane + 64 * j); v[j] = v[j] * rstd * gg + bb; }
}
__device__ __forceinline__ void ln_vals(f32x4 (&v)[4], const float* g, const float* b, int lane) {
    float s = 0.f;
#pragma unroll
    for (int j = 0; j < 4; ++j) s += (v[j].x + v[j].y) + (v[j].z + v[j].w);
    const float mean = wave_sum(s) * (1.f / D); float s2 = 0.f;
#pragma unroll
    for (int j = 0; j < 4; ++j) { v[j] = v[j] - mean; s2 += (v[j].x * v[j].x + v[j].y * v[j].y) + (v[j].z * v[j].z + v[j].w * v[j].w); }
    const float rstd = 1.f / sqrtf(wave_sum(s2) * (1.f / D) + LN_EPS);
#pragma unroll
    for (int j = 0; j < 4; ++j) { const f32x4 gg = *((const f32x4*)g + lane + 64 * j), bb = *((const f32x4*)b + lane + 64 * j); v[j] = v[j] * rstd * gg + bb; }
}
__device__ __forceinline__ void ln_row_bf(const bf16* xrow, const float* g, const float* b, int lane, f32x4 (&v)[4]) {
    float s = 0.f;
#pragma unroll
    for (int j = 0; j < 4; ++j) { const u32x2 w = *((const u32x2*)xrow + lane + 64 * j); v[j] = (f32x4){bf_lo(w.x), bf_hi(w.x), bf_lo(w.y), bf_hi(w.y)}; s += (v[j].x + v[j].y) + (v[j].z + v[j].w); }
    const float mean = wave_sum(s) * (1.f / D); float s2 = 0.f;
#pragma unroll
    for (int j = 0; j < 4; ++j) { v[j] = v[j] - mean; s2 += (v[j].x * v[j].x + v[j].y * v[j].y) + (v[j].z * v[j].z + v[j].w * v[j].w); }
    const float rstd = 1.f / sqrtf(wave_sum(s2) * (1.f / D) + LN_EPS);
#pragma unroll
    for (int j = 0; j < 4; ++j) { const f32x4 gg = *((const f32x4*)g + lane + 64 * j), bb = *((const f32x4*)b + lane + 64 * j); v[j] = v[j] * rstd * gg + bb; }
}
__device__ __forceinline__ void store_row_bf16(bf16* orow, int lane, const f32x4 (&v)[4]) {
#pragma unroll
    for (int j = 0; j < 4; ++j) { u32x2 w; w.x = cvt_pk_bf16(v[j].x, v[j].y); w.y = cvt_pk_bf16(v[j].z, v[j].w); *((u32x2*)orow + lane + 64 * j) = w; }
}

__device__ __forceinline__ void p0_prologue(const Frame& F, const Args& a) {
    unsigned char* ws = a.ws;
    if (blockIdx.x < 24) {
        LAS float* hm = (LAS float*)F.lds;
        LAS float* part = (LAS float*)(F.lds + 65536);
        for (int r = F.wave * 2; r < F.wave * 2 + 2; ++r) { f32x4 v[4]; ln_row(a.in[I_META] + (size_t)r * D, a.in[I_LNIG], a.in[I_LNIB], F.lane, v);
#pragma unroll
            for (int j = 0; j < 4; ++j) *((LAS f32x4*)(hm + r * 1024) + F.lane + 64 * j) = v[j]; }
        __syncthreads();
        const int cgp = blockIdx.x; const int col = (cgp < 16 ? cgp * 64 : 2048 + (cgp - 16) * 64) + F.lane;
        float acc[16];
#pragma unroll
        for (int t = 0; t < 16; ++t) acc[t] = 0.f;
        const float* w = a.in[I_WIN];
        for (int k = F.wave * 128; k < F.wave * 128 + 128; k += 4) {
            const float w0 = w[(size_t)(k + 0) * NPROJ + col], w1 = w[(size_t)(k + 1) * NPROJ + col], w2 = w[(size_t)(k + 2) * NPROJ + col], w3 = w[(size_t)(k + 3) * NPROJ + col];
#pragma unroll
            for (int t = 0; t < 16; ++t) { const f32x4 h = *(const LAS f32x4*)(hm + t * 1024 + k); acc[t] += h.x * w0 + h.y * w1 + h.z * w2 + h.w * w3; }
        }
#pragma unroll
        for (int t = 0; t < 16; ++t) part[(F.wave * 16 + t) * 64 + F.lane] = acc[t];
        __syncthreads();
        float* PROJM = (float*)(ws + WS_PROJM);
        for (int idx = F.tid; idx < 16 * 64; idx += NTHREADS) { const int t = idx >> 6, l = idx & 63; float s = 0.f;
#pragma unroll
            for (int w8 = 0; w8 < 8; ++w8) s += part[(w8 * 16 + t) * 64 + l];
            PROJM[t * 1536 + cgp * 64 + l] = s; }
        __syncthreads();
    }
    if (blockIdx.x == F.G - 1) { float* LS8 = (float*)(ws + WS_LS8);
        for (int c = F.tid; c < D; c += NTHREADS) { const float L = a.in[I_LRUL][c]; LS8[c] = 8.f * (fminf(L, 0.f) - log1pf(expf(-fabsf(L)))); } }
    { const float *pw = a.in[I_POOLW], *ps = a.in[I_POOLS], *wpb = a.in[I_WPB]; bf16* BC = (bf16*)(ws + WS_BCAT);
      for (int it = F.gw; it < 128 * 16; it += F.NGW) { const int k0 = (it >> 4) * 4, eb = it & 15, gI = k0 >> 7;
          float pa[4], pb[4], acc[4];
#pragma unroll
          for (int i = 0; i < 4; ++i) { pa[i] = pw[(size_t)(k0 + i) * 128 + F.lane] * ps[gI * 128 + F.lane]; pb[i] = pw[(size_t)(k0 + i) * 128 + 64 + F.lane] * ps[gI * 128 + 64 + F.lane]; acc[i] = 0.f; }
          const float* wcol = wpb + (size_t)(gI * 128) * D + eb * 64 + F.lane;
#pragma unroll 8
          for (int d = 0; d < 64; ++d) { const float w = wcol[(size_t)d * D];
#pragma unroll
              for (int i = 0; i < 4; ++i) acc[i] += __builtin_bit_cast(float, __builtin_amdgcn_readlane(__builtin_bit_cast(int, pa[i]), d)) * w; }
#pragma unroll 8
          for (int d = 0; d < 64; ++d) { const float w = wcol[(size_t)(64 + d) * D];
#pragma unroll
              for (int i = 0; i < 4; ++i) acc[i] += __builtin_bit_cast(float, __builtin_amdgcn_readlane(__builtin_bit_cast(int, pb[i]), d)) * w; }
          u32x2 o; o.x = cvt_pk_bf16(acc[0], acc[1]); o.y = cvt_pk_bf16(acc[2], acc[3]);
          *(u32x2*)(BC + (size_t)(eb * 64 + F.lane) * 1536 + k0) = o; } }
    { LAS float* scr = (LAS float*)(F.lds + F.wave * 16384);
      constexpr int I_IN = 16 * 144, I_PA = 16 * 32, I_OUT = 16 * 32, I_Q = 16 * 64, I_G = 8 * 32;
      constexpr int NIT = I_IN + I_PA + I_OUT + I_Q + I_G;
      for (int it = F.gw; it < NIT; it += F.NGW) { int r = it;
          if (r < I_IN) { const int kb = r / 144, nb = r % 144; transpose_item(a.in[I_WIN] + (size_t)(64 * kb) * NPROJ + 32 * nb, NPROJ, (bf16*)(ws + WS_WINT) + (size_t)(32 * nb) * 1024 + 64 * kb, 1024, scr, F.lane); continue; } r -= I_IN;
          if (r < I_PA) { const int kb = r / 32, nb = r % 32; transpose_item(a.in[I_WPA] + (size_t)(64 * kb) * D + 32 * nb, D, (bf16*)(ws + WS_BCAT) + (size_t)(32 * nb) * 1536 + 512 + 64 * kb, 1536, scr, F.lane); continue; } r -= I_PA;
          if (r < I_OUT) { const int kb = r / 32, nb = r % 32; transpose_item(a.in[I_WOUT] + (size_t)(64 * kb) * D + 32 * nb, D, (bf16*)(ws + WS_WOUTT) + (size_t)(32 * nb) * 1024 + 64 * kb, 1024, scr, F.lane); continue; } r -= I_OUT;
          if (r < I_Q) { const int kb = r / 64, nb = r % 64; transpose_item(a.in[I_WQ] + (size_t)(64 * kb) * 2048 + 32 * nb, 2048, (bf16*)(ws + WS_WQT) + (size_t)(32 * nb) * 1024 + 64 * kb, 1024, scr, F.lane); continue; } r -= I_Q;
          { const int mat = r / 32, rr = r % 32, kb = rr / 8, nb = rr % 8, gate = mat >> 2, n = mat & 3;
            const float* src = a.in[gate ? I_WIG : I_WRG] + (size_t)n * 65536 + (size_t)(64 * kb) * 256 + 32 * nb;
            const int n0 = 32 * nb, drow = (n * 2 + (n0 >> 7)) * 256 + gate * 128 + (n0 & 127);
            transpose_item(src, 256, (bf16*)(ws + WS_GATET) + (size_t)drow * 256 + 64 * kb, 256, scr, F.lane); } } }
    { const float* sk = a.in[I_KEYS]; bf16* kd = (bf16*)(ws + WS_KEYS);
      for (int i = F.gw * 64 + F.lane; i < 8 * 2 * 128 * 128 / 8; i += F.NGW * 64) { const f32x4 x0 = *((const f32x4*)sk + 2 * i), x1 = *((const f32x4*)sk + 2 * i + 1);
          u32x4 o; o.x = cvt_pk_bf16(x0.x, x0.y); o.y = cvt_pk_bf16(x0.z, x0.w); o.z = cvt_pk_bf16(x1.x, x1.y); o.w = cvt_pk_bf16(x1.z, x1.w); *((u32x4*)kd + i) = o; } }
    { bf16* H0 = (bf16*)(ws + WS_H0);
      f32x4 nx[4];
#pragma unroll
      for (int j = 0; j < 4; ++j) nx[j] = *((const f32x4*)(a.in[I_X] + (size_t)(F.gw < M ? F.gw : 0) * D) + F.lane + 64 * j);
#pragma unroll 1
      for (int m = F.gw; m < M; m += F.NGW) { f32x4 v[4]; const int mn = m + F.NGW < M ? m + F.NGW : m;
#pragma unroll
          for (int j = 0; j < 4; ++j) { v[j] = nx[j]; nx[j] = *((const f32x4*)(a.in[I_X] + (size_t)mn * D) + F.lane + 64 * j); }
          ln_vals(v, a.in[I_LNIG], a.in[I_LNIB], F.lane); store_row_bf16(H0 + (size_t)m * D, F.lane, v);
          const float am = fmaxf(absmax4(v), 1e-20f), inv = 127.f / am;
#pragma unroll
          for (int j = 0; j < 4; ++j) *((unsigned*)(ws + WS_H0Q + (size_t)m * D) + F.lane + 64 * j) = pack_i8x4(v[j], inv);
          if (F.lane == 0) ((float*)(ws + WS_SA))[m] = am * (1.f / 127.f); } }
}

__device__ __forceinline__ void p2_convpool(const Frame& F, const Args& a) {
    unsigned char* ws = a.ws; const float* PROJM = (const float*)(ws + WS_PROJM);
    if (blockIdx.x < 4) {
        const int n = blockIdx.x; LAS float* xcm = (LAS float*)F.lds;
        for (int idx = F.tid; idx < 4096; idx += NTHREADS) { const int t = idx >> 8, c = n * 256 + (idx & 255); float v = a.in[I_CONVB][c];
#pragma unroll
            for (int jj = 0; jj < 4; ++jj) { const int tt = t + jj - 3; if (tt >= 0) v += a.in[I_CONVW][jj * D + c] * PROJM[tt * 1536 + c]; }
            xcm[idx] = v; }
        __syncthreads();
        if (F.wave < 4) { const int cl = F.wave * 64 + F.lane, c = n * 256 + cl; float rl[16], il[16];
#pragma unroll
            for (int t = 0; t < 16; ++t) { rl[t] = 0.f; il[t] = 0.f; }
#pragma unroll 8
            for (int k = 0; k < 256; ++k) { const float wr_ = a.in[I_WRG][(size_t)(n * 256 + k) * 256 + cl], wi_ = a.in[I_WIG][(size_t)(n * 256 + k) * 256 + cl];
#pragma unroll
                for (int t = 0; t < 16; ++t) { const float x = xcm[t * 256 + k]; rl[t] += x * wr_; il[t] += x * wi_; } }
            const float brg = a.in[I_BRG][c], big = a.in[I_BIG][c], ls8 = ((const float*)(ws + WS_LS8))[c]; float h = 0.f;
#pragma unroll
            for (int t = 0; t < 16; ++t) { const float r = sigmoidf_(rl[t] + brg), ig = sigmoidf_(il[t] + big); const float l = ls8 * r; const float aa = fast_exp(l);
                const float em = -expm1f(2.f * l); h = aa * h + sqrtf(em) * ig * xcm[t * 256 + cl]; }
            ((float*)(ws + WS_HMETA))[c] = h; }
        __syncthreads();
    }
    { const bf16* XR = (const bf16*)(ws + WS_XR); bf16* XC = (bf16*)(ws + WS_XC); const float *cw = a.in[I_CONVW], *cb = a.in[I_CONVB];
      const int gt = blockIdx.x * NTHREADS + F.tid, GT = F.G * NTHREADS;
      for (int idx = gt; idx < (M / 8) * 128; idx += GT) { const int row0 = (idx >> 7) * 8, c0 = (idx & 127) * 8, t0 = row0 & (SEQ - 1);
          u32x4 xw[11];
          if (t0 >= 8) {
#pragma unroll
              for (int i = 0; i < 11; ++i) xw[i] = *(const u32x4*)(XR + (size_t)(row0 - 3 + i) * D + c0);
          } else {
#pragma unroll
              for (int i = 0; i < 11; ++i) { const int tt = t0 - 3 + i;
                  if (tt >= 0) xw[i] = *(const u32x4*)(XR + (size_t)(row0 - 3 + i) * D + c0);
                  else { float x[8];
#pragma unroll
                      for (int e = 0; e < 8; ++e) x[e] = PROJM[(NMETA + tt) * 1536 + c0 + e];
                      xw[i] = pack8(x); } } }
          float w4[4][8], b8[8];
#pragma unroll
          for (int e = 0; e < 8; ++e) { b8[e] = cb[c0 + e];
#pragma unroll
              for (int jj = 0; jj < 4; ++jj) w4[jj][e] = cw[jj * D + c0 + e]; }
#pragma unroll
          for (int r = 0; r < 8; ++r) { float x0[8], x1[8], x2[8], x3[8], o[8]; unpack8(xw[r], x0); unpack8(xw[r + 1], x1); unpack8(xw[r + 2], x2); unpack8(xw[r + 3], x3);
#pragma unroll
              for (int e = 0; e < 8; ++e) o[e] = b8[e] + w4[0][e] * x0[e] + w4[1][e] * x1[e] + w4[2][e] * x2[e] + w4[3][e] * x3[e];
              *(u32x4*)(XC + (size_t)(row0 + r) * D + c0) = pack8(o); } }
      const bf16* XP = (const bf16*)(ws + WS_XP); bf16* PO = (bf16*)(ws + WS_ACAT);
      for (int idx = gt; idx < (M / 4) * 64; idx += GT) { const int row0 = (idx >> 6) * 4, c0 = (idx & 63) * 8, t0 = row0 & (SEQ - 1), w = 2 << (c0 >> 7);
          float X[19][8];
          if (t0 >= 16) { u32x4 xw[19];
#pragma unroll
              for (int i = 0; i < 19; ++i) xw[i] = (i >= 16 - w) ? *(const u32x4*)(XP + (size_t)(row0 - 15 + i) * DPOOL + c0) : (u32x4){0u, 0u, 0u, 0u};
#pragma unroll
              for (int i = 0; i < 19; ++i) unpack8(xw[i], X[i]);
          } else {
#pragma unroll
              for (int i = 0; i < 19; ++i) { const int tt = t0 - 15 + i;
                  if (tt >= 0) unpack8(*(const u32x4*)(XP + (size_t)(row0 - 15 + i) * DPOOL + c0), X[i]);
                  else {
#pragma unroll
                      for (int e = 0; e < 8; ++e) X[i][e] = PROJM[(NMETA + tt) * 1536 + 1024 + c0 + e]; } } }
          const float inv = 1.f / (float)w;
#pragma unroll
          for (int r = 0; r < 4; ++r) { float s[8];
#pragma unroll
              for (int e = 0; e < 8; ++e) s[e] = 0.f;
#pragma unroll
              for (int j = 0; j < 16; ++j) { const bool on = j < w;
#pragma unroll
                  for (int e = 0; e < 8; ++e) s[e] += on ? X[15 + r - j][e] : 0.f; }
              float o[8];
#pragma unroll
              for (int e = 0; e < 8; ++e) o[e] = s[e] * inv - X[15 + r][e];
              *(u32x4*)(PO + (size_t)(row0 + r) * ACAT_LD + c0) = pack8(o); } } }
}

__device__ __forceinline__ void p4_scan_agg(const Frame& F, const Args& a) {
    unsigned char* ws = a.ws; const bf16* LOGA = (const bf16*)(ws + WS_LOGA); const bf16* BB = (const bf16*)(ws + WS_BB);
    float* AGG = (float*)(ws + WS_AGG); float* SUB = (float*)(ws + WS_SUBAGG);
    LAS float* sh = (LAS float*)F.lds;
    const int s = F.tid >> 7, o = F.tid & 127;
    for (int item = blockIdx.x; item < 256; item += F.G) {
        const size_t row0 = (size_t)item * 256 + s * 64;
        float sl[8], S[8];
#pragma unroll
        for (int e = 0; e < 8; ++e) { sl[e] = 0.f; S[e] = 0.f; }
#pragma unroll 4
        for (int r = 0; r < 64; ++r) { float la[8], bb[8]; unpack8(*(const u32x4*)(LOGA + (row0 + r) * D + o * 8), la); unpack8(*(const u32x4*)(BB + (row0 + r) * D + o * 8), bb);
#pragma unroll
            for (int e = 0; e < 8; ++e) { sl[e] += la[e]; S[e] = fast_exp(la[e]) * S[e] + bb[e]; } }
#pragma unroll
        for (int e = 0; e < 8; ++e) { sh[((s * 1024) + o * 8 + e) * 2] = sl[e]; sh[((s * 1024) + o * 8 + e) * 2 + 1] = S[e];
            SUB[(((size_t)item * 4 + s) * 1024 + o * 8 + e) * 2] = sl[e]; SUB[(((size_t)item * 4 + s) * 1024 + o * 8 + e) * 2 + 1] = S[e]; }
        __syncthreads();
        for (int c = F.tid; c < 1024; c += NTHREADS) { float tl = 0.f, tS = 0.f;
#pragma unroll
            for (int k = 0; k < 4; ++k) { const float l = sh[(k * 1024 + c) * 2], Sk = sh[(k * 1024 + c) * 2 + 1]; tS = fast_exp(l) * tS + Sk; tl += l; }
            AGG[((size_t)item * 1024 + c) * 2] = tl; AGG[((size_t)item * 1024 + c) * 2 + 1] = tS; }
        __syncthreads();
    }
}
__device__ __forceinline__ void p5_scan_apply(const Frame& F, const Args& a) {
    unsigned char* ws = a.ws; const bf16* LOGA = (const bf16*)(ws + WS_LOGA); const bf16* BB = (const bf16*)(ws + WS_BB); bf16* RG = (bf16*)(ws + WS_ACAT) + 512;
    const float* AGG = (const float*)(ws + WS_AGG); const float* SUB = (const float*)(ws + WS_SUBAGG); const float* HMETA = (const float*)(ws + WS_HMETA);
    LAS float* carry = (LAS float*)F.lds;
    const int s = F.tid >> 7, o = F.tid & 127;
    for (int item = blockIdx.x; item < 256; item += F.G) {
        const int b = item >> 5, ch = item & 31;
        for (int c = F.tid; c < 1024; c += NTHREADS) { float h = HMETA[c];
            for (int cc = 0; cc < ch; ++cc) { const float l = AGG[((size_t)(b * 32 + cc) * 1024 + c) * 2], Sk = AGG[((size_t)(b * 32 + cc) * 1024 + c) * 2 + 1]; h = fast_exp(l) * h + Sk; }
            carry[c] = h; }
        __syncthreads();
        float h[8];
#pragma unroll
        for (int e = 0; e < 8; ++e) h[e] = carry[o * 8 + e];
        for (int ss = 0; ss < s; ++ss) {
#pragma unroll
            for (int e = 0; e < 8; ++e) { const float l = SUB[(((size_t)item * 4 + ss) * 1024 + o * 8 + e) * 2], Sk = SUB[(((size_t)item * 4 + ss) * 1024 + o * 8 + e) * 2 + 1]; h[e] = fast_exp(l) * h[e] + Sk; } }
        const size_t row0 = (size_t)item * 256 + s * 64;
#pragma unroll 4
        for (int r = 0; r < 64; ++r) { float la[8], bb[8], gt[8]; const size_t off = (row0 + r) * D + o * 8;
            const size_t offg = (row0 + r) * ACAT_LD + o * 8;
            unpack8(*(const u32x4*)(LOGA + off), la); unpack8(*(const u32x4*)(BB + off), bb); unpack8(*(const u32x4*)(RG + offg), gt); float ov[8];
#pragma unroll
            for (int e = 0; e < 8; ++e) { h[e] = fast_exp(la[e]) * h[e] + bb[e]; ov[e] = h[e] * gelu_tanh(gt[e]); }
            *(u32x4*)(RG + offg) = pack8(ov); }
        __syncthreads();
    }
}

__device__ __forceinline__ void p8_ln1(const Frame& F, const Args& a) {
    unsigned char* ws = a.ws; const bf16* V1 = (const bf16*)(ws + WS_V1); bf16* H1 = (bf16*)(ws + WS_H1);
    unsigned char* H8 = ws + WS_H8; float* SH = (float*)(ws + WS_SH);
    u32x2 nx[4];
#pragma unroll
    for (int j = 0; j < 4; ++j) nx[j] = *((const u32x2*)(V1 + (size_t)(F.gw < M ? F.gw : 0) * D) + F.lane + 64 * j);
#pragma unroll 1
    for (int m = F.gw; m < M; m += F.NGW) { f32x4 v[4]; const int mn = m + F.NGW < M ? m + F.NGW : m;
#pragma unroll
        for (int j = 0; j < 4; ++j) { v[j] = (f32x4){bf_lo(nx[j].x), bf_hi(nx[j].x), bf_lo(nx[j].y), bf_hi(nx[j].y)}; nx[j] = *((const u32x2*)(V1 + (size_t)mn * D) + F.lane + 64 * j); }
        ln_vals(v, a.in[I_LN1G], a.in[I_LN1B], F.lane); store_row_bf16(H1 + (size_t)m * D, F.lane, v);
        const float am = fmaxf(absmax4(v), 1e-20f), inv = 127.f / am;
        u32x4 q; q.x = pack_i8x4(v[0], inv); q.y = pack_i8x4(v[1], inv); q.z = pack_i8x4(v[2], inv); q.w = pack_i8x4(v[3], inv);
        *((u32x4*)(H8 + (size_t)m * D) + F.lane) = q; if (F.lane == 0) SH[m] = am * (1.f / 127.f); }
    { const bf16* WT = (const bf16*)(ws + WS_WQT); unsigned char* WQ8 = ws + WS_WQ8; float* SQ = (float*)(ws + WS_SQ);
      for (int r = F.gw; r < 2048; r += F.NGW) { f32x4 v[4];
#pragma unroll
          for (int j = 0; j < 4; ++j) { const u32x2 w = *((const u32x2*)(WT + (size_t)r * 1024) + F.lane + 64 * j); v[j] = (f32x4){bf_lo(w.x), bf_hi(w.x), bf_lo(w.y), bf_hi(w.y)}; }
          const float am = fmaxf(absmax4(v), 1e-20f), inv = 127.f / am;
          u32x4 q; q.x = pack_i8x4(v[0], inv); q.y = pack_i8x4(v[1], inv); q.z = pack_i8x4(v[2], inv); q.w = pack_i8x4(v[3], inv);
          *((u32x4*)(WQ8 + (size_t)r * 1024) + F.lane) = q; if (F.lane == 0) SQ[r] = am * (1.f / 127.f); } }
}
__device__ __forceinline__ void convert_tables(const Frame& F, const Args& a) {
    unsigned char* ws = a.ws;
    unsigned char* U8 = ws + WS_U8; unsigned char* V8 = ws + WS_V8; unsigned* SUV = (unsigned*)(ws + WS_SU);
    f32x4 un[4], vn[4];
    { const int e0 = F.gw < 16384 ? F.gw : 0;
#pragma unroll
      for (int j = 0; j < 4; ++j) { un[j] = *((const f32x4*)(a.in[I_EU] + (size_t)e0 * D) + F.lane + 64 * j); vn[j] = *((const f32x4*)(a.in[I_EV] + (size_t)e0 * D) + F.lane + 64 * j); } }
#pragma unroll 1
    for (int e = F.gw; e < 16384; e += F.NGW) { f32x4 u[4], v[4];
#pragma unroll
        for (int j = 0; j < 4; ++j) { u[j] = un[j]; v[j] = vn[j]; }
        { const int en = e + F.NGW < 16384 ? e + F.NGW : e;
#pragma unroll
          for (int j = 0; j < 4; ++j) { un[j] = *((const f32x4*)(a.in[I_EU] + (size_t)en * D) + F.lane + 64 * j); vn[j] = *((const f32x4*)(a.in[I_EV] + (size_t)en * D) + F.lane + 64 * j); } }
        const float amu = fmaxf(absmax4(u), 1e-20f), amv = fmaxf(absmax4(v), 1e-20f);
        const unsigned sc = cvt_pk_bf16(amu * (1.f / 127.f) * 1.004f, amv * (1.f / 127.f) * 1.004f);
        const float invu = 1.f / bf_lo(sc), invv = 1.f / bf_hi(sc);
        u32x4 q; q.x = pack_i8x4(u[0], invu); q.y = pack_i8x4(u[1], invu); q.z = pack_i8x4(u[2], invu); q.w = pack_i8x4(u[3], invu);
        *((u32x4*)(U8 + (size_t)e * D) + F.lane) = q;
#pragma unroll
        for (int j = 0; j < 4; ++j) *((unsigned*)(V8 + (size_t)e * D) + F.lane + 64 * j) = pack_i8x4(v[j], invv);
        if (F.lane == 0) SUV[e] = sc; }
}

constexpr int KPITCH = 272;
typedef float f32x16 __attribute__((ext_vector_type(16)));
__device__ __forceinline__ void ce_desc(float& a, float& b) { float hi, lo; asm("v_max_f32 %0, %1, %2" : "=v"(hi) : "v"(a), "v"(b)); asm("v_min_f32 %0, %1, %2" : "=v"(lo) : "v"(a), "v"(b)); a = hi; b = lo; }
__device__ __forceinline__ float max_asm(float a, float b) { float hi; asm("v_max_f32 %0, %1, %2" : "=v"(hi) : "v"(a), "v"(b)); return hi; }
template <int B> __device__ __forceinline__ void sort16_desc(float (&v)[64]) {
#define S16(a, b) ce_desc(v[B + a], v[B + b]);
    S16(0,13) S16(1,12) S16(2,15) S16(3,14) S16(4,8) S16(5,6) S16(7,11) S16(9,10)
    S16(0,5) S16(1,7) S16(2,9) S16(3,4) S16(6,13) S16(8,14) S16(10,15) S16(11,12)
    S16(0,1) S16(2,3) S16(4,5) S16(6,8) S16(7,9) S16(10,11) S16(12,13) S16(14,15)
    S16(0,2) S16(1,3) S16(4,10) S16(5,11) S16(6,7) S16(8,9) S16(12,14) S16(13,15)
    S16(1,2) S16(3,12) S16(4,6) S16(5,7) S16(8,10) S16(9,11) S16(13,14)
    S16(1,4) S16(2,6) S16(5,8) S16(7,10) S16(9,13) S16(11,14)
    S16(2,4) S16(3,6) S16(9,12) S16(11,13)
    S16(3,5) S16(6,8) S16(7,9) S16(10,12)
    S16(3,4) S16(5,6) S16(7,8) S16(9,10) S16(11,12)
    S16(6,7) S16(8,9)
#undef S16
}
template <int B> __device__ __forceinline__ void bitonic_merge16(float (&v)[64]) {
#pragma unroll
    for (int j = 8; j > 0; j >>= 1)
#pragma unroll
        for (int i = 0; i < 16; ++i) { const int l = i ^ j; if (l > i) ce_desc(v[B + i], v[B + l]); }
}
template <int A, int B> __device__ __forceinline__ void merge_top16(float (&v)[64]) {
#pragma unroll
    for (int i = 0; i < 16; ++i) v[A + i] = max_asm(v[A + i], v[B + 15 - i]);
    bitonic_merge16<A>(v);
}
__device__ __forceinline__ void top16_of_64(float (&v)[64]) { sort16_desc<0>(v); sort16_desc<16>(v); sort16_desc<32>(v); sort16_desc<48>(v); merge_top16<0, 16>(v); merge_top16<32, 48>(v); merge_top16<0, 32>(v); }

__device__ __forceinline__ void p10_retrieve(const Frame& F, const Args& a) {
    unsigned char* ws = a.ws; const bf16* Q = (const bf16*)(ws + WS_Q); const bf16* KEYS = (const bf16*)(ws + WS_KEYS);
    unsigned* IDW = (unsigned*)(ws + WS_IDW);
    LAS unsigned char* kl = F.lds;
    const int h = blockIdx.x & 7, rank = blockIdx.x >> 3, nblk = (F.G - h + 7) >> 3;
    for (int pc = F.tid; pc < 2 * 128 * 16; pc += NTHREADS) { const int rowk = pc >> 4, ch = pc & 15;
        *(LAS u32x4*)(kl + rowk * KPITCH + ch * 16) = *((const u32x4*)(KEYS + (size_t)h * 2 * 128 * 128) + pc); }
    __syncthreads();
    if (F.wave < 4) convert_tables(F, a);
    const int tl = F.lane & 31, hh = F.lane >> 5;
    const unsigned hh4 = (unsigned)hh * 4u;
    bf16x8 q0[8], q1[8];
    { const size_t tok0 = (size_t)(rank * NWAVES + F.wave < M / 32 ? rank * NWAVES + F.wave : 0) * 32 + tl;
#pragma unroll
      for (int s = 0; s < 8; ++s) q0[s] = *(const bf16x8*)(Q + tok0 * 2048 + h * 256 + 16 * s + 8 * hh); }
#pragma unroll 1
    for (int grp = rank * NWAVES + F.wave; grp < M / 32; grp += nblk * NWAVES) {
        const size_t tok = (size_t)grp * 32 + tl;
        const int gn = grp + nblk * NWAVES; const size_t tokn = (size_t)(gn < M / 32 ? gn : grp) * 32 + tl;
        float res[2][16];
#pragma unroll
        for (int p = 0; p < 2; ++p) {
            bf16x8 qc[8];
#pragma unroll
            for (int s = 0; s < 8; ++s) qc[s] = p ? q1[s] : q0[s];
            if (p == 0) {
#pragma unroll
                for (int s = 0; s < 8; ++s) q1[s] = *(const bf16x8*)(Q + tok * 2048 + h * 256 + 128 + 16 * s + 8 * hh);
            } else {
#pragma unroll
                for (int s = 0; s < 8; ++s) q0[s] = *(const bf16x8*)(Q + tokn * 2048 + h * 256 + 16 * s + 8 * hh);
            }
            f32x16 acc[4];
#pragma unroll
            for (int kb = 0; kb < 4; ++kb)
#pragma unroll
                for (int r = 0; r < 16; ++r) acc[kb][r] = 0.f;
#pragma unroll
            for (int s = 0; s < 8; ++s)
#pragma unroll
                for (int kb = 0; kb < 4; ++kb) { const bf16x8 kf = *(const LAS bf16x8*)(kl + (p * 128 + kb * 32 + tl) * KPITCH + (16 * s + 8 * hh) * 2);
                    acc[kb] = __builtin_amdgcn_mfma_f32_32x32x16_bf16(kf, qc[s], acc[kb], 0, 0, 0); }
            float v[64];
#pragma unroll
            for (int kb = 0; kb < 4; ++kb)
#pragma unroll
                for (int r = 0; r < 16; ++r) v[kb * 16 + r] = __uint_as_float(((__float_as_uint(acc[kb][r]) & 0xFFFFFF80u) | hh4) | (unsigned)(32 * kb + 8 * (r >> 2) + (r & 3)));
            top16_of_64(v);
#pragma unroll
            for (int i = 0; i < 16; ++i) {
                auto rr = __builtin_amdgcn_permlane32_swap(__float_as_uint(v[15 - i]), __float_as_uint(v[15 - i]), false, false);
                const float partner = __uint_as_float(hh ? rr[0] : rr[1]);
                v[16 + i] = max_asm(v[i], partner); }
            bitonic_merge16<16>(v);
#pragma unroll
            for (int i = 0; i < 16; ++i) res[p][i] = v[16 + i];
            __builtin_amdgcn_sched_barrier(0);
        }
        float v[64]; unsigned i0[16], j1[16];
#pragma unroll
        for (int i = 0; i < 16; ++i) { i0[i] = (__float_as_uint(res[0][i]) & 127u) << 7; j1[i] = __float_as_uint(res[1][i]) & 127u; }
        { int n = 0;
#pragma unroll
          for (int i = 0; i < 16; ++i)
#pragma unroll
              for (int j = 0; j < 16; ++j) if ((i + 1) * (j + 1) <= 16) { v[n] = __uint_as_float((__float_as_uint(res[0][i] + res[1][j]) & 0xFFFFC000u) | i0[i] | j1[j]); ++n; }
#pragma unroll
          for (int q = 50; q < 64; ++q) v[q] = -INFINITY; }
        top16_of_64(v);
        float e[16], sum = 0.f; const float mx = __uint_as_float(__float_as_uint(v[0]) & 0xFFFFC000u);
#pragma unroll
        for (int r = 0; r < 16; ++r) { e[r] = fast_exp(__uint_as_float(__float_as_uint(v[r]) & 0xFFFFC000u) - mx); sum += e[r]; }
        const float inv = 1.f / sum;
        {
            u32x4* o = (u32x4*)(IDW + tok * NSEL + h * 16 + 8 * hh);
#pragma unroll
            for (int q = 0; q < 2; ++q) { u32x4 w4;
#pragma unroll
                for (int c = 0; c < 4; ++c) { const float va = v[4 * q + c], vb = v[8 + 4 * q + c]; const float ea = e[4 * q + c], eb = e[8 + 4 * q + c];
                    const float vv = hh ? vb : va, ee = hh ? eb : ea; w4[c] = ((__float_as_uint(vv) & 0x3FFFu) << 16) | (cvt_pk_bf16(ee * inv, 0.f) & 0xFFFFu); }
                o[q] = w4; } }
    }
    if (F.wave >= 4) convert_tables(F, a);
}

typedef int i32x4 __attribute__((ext_vector_type(4)));
template <int CTRL> __device__ __forceinline__ int dpp_i(int v) { return __builtin_amdgcn_update_dpp(0, v, CTRL, 0xf, 0xf, true); }
struct URaw { unsigned xa, xb; u32x4 h; float sh; int tok; };
struct UMeta8 { int idv, kv, n; float wv, su, sv, sh; u32x4 h; int tok; };
__device__ __forceinline__ void u_prep(URaw& r, int tok, const unsigned* IDW, const unsigned char* H8, const float* SH, int lane) {
    r.tok = tok; const size_t tc = (size_t)(tok < M ? tok : M - 1);
    r.xa = IDW[tc * NSEL + lane]; r.xb = IDW[tc * NSEL + 64 + lane];
    r.h = *((const u32x4*)(H8 + tc * D) + lane); r.sh = SH[tc]; }
__device__ __forceinline__ void u_fetch(UMeta8& m, LAS i32x4* slots, int base, int lane16or32, const LAS unsigned* SUV) {
    const i32x4 e = slots[base + lane16or32]; const bool valid = base + lane16or32 < m.n;
    m.idv = valid ? (int)((unsigned)e.x >> 16) : 0; m.wv = valid ? __uint_as_float((unsigned)e.x << 16) : 0.f; m.kv = e.z; { const unsigned sc = SUV[m.idv & 2047]; m.su = bf_lo(sc); m.sv = bf_hi(sc); } }
__device__ __forceinline__ void u_compact(const URaw& r, UMeta8& m, LAS i32x4* slots, int label, const LAS unsigned* SUV, int lane) {
    const bool ina = (int)(r.xa >> 27) == label, inb = (int)(r.xb >> 27) == label;
    const unsigned long long ma = __ballot(ina), mb = __ballot(inb); const int na = __popcll(ma); m.n = na + __popcll(mb);
    const int ra = __builtin_amdgcn_mbcnt_hi((unsigned)(ma >> 32), __builtin_amdgcn_mbcnt_lo((unsigned)ma, 0)), rb = na + __builtin_amdgcn_mbcnt_hi((unsigned)(mb >> 32), __builtin_amdgcn_mbcnt_lo((unsigned)mb, 0));
    if (ina) slots[ra] = (i32x4){(int)r.xa, 0, lane, 0}; if (inb) slots[rb] = (i32x4){(int)r.xb, 0, 64 + lane, 0};
    m.h = r.h; m.sh = r.sh; m.tok = r.tok;
    u_fetch(m, slots, 0, lane & 31, SUV); }
template <int S0> __device__ __forceinline__ void u_issue16(int idv, int n, u32x4 (&buf)[16], const unsigned char* U8, int lane) {
#pragma unroll
    for (int s = 0; s < 16; ++s) if (S0 + s < n) { const int id = __builtin_amdgcn_readlane(idv, S0 + s); buf[s] = *((const u32x4*)(U8 + (size_t)id * D) + lane); }
}
__device__ __forceinline__ int u_dot16(const u32x4 (&buf)[16], const u32x4 h, int lane) {
    int d[16];
#pragma unroll
    for (int s = 0; s < 16; ++s) { int t = __builtin_amdgcn_sdot4((int)buf[s].x, (int)h.x, 0, false); t = __builtin_amdgcn_sdot4((int)buf[s].y, (int)h.y, t, false);
        t = __builtin_amdgcn_sdot4((int)buf[s].z, (int)h.z, t, false); d[s] = __builtin_amdgcn_sdot4((int)buf[s].w, (int)h.w, t, false); }
    const bool b0 = lane & 1, b1 = lane & 2, b2 = lane & 4, b3 = lane & 8;
    int r1[8], r2[4], r3[2];
#pragma unroll
    for (int p = 0; p < 8; ++p) { const int keep = b0 ? d[2 * p + 1] : d[2 * p], send = b0 ? d[2 * p] : d[2 * p + 1]; r1[p] = keep + dpp_i<0xB1>(send); }
#pragma unroll
    for (int p = 0; p < 4; ++p) { const int keep = b1 ? r1[2 * p + 1] : r1[2 * p], send = b1 ? r1[2 * p] : r1[2 * p + 1]; r2[p] = keep + dpp_i<0x4E>(send); }
#pragma unroll
    for (int p = 0; p < 2; ++p) { const int keep = b2 ? r2[2 * p + 1] : r2[2 * p], send = b2 ? r2[2 * p] : r2[2 * p + 1]; r3[p] = keep + __builtin_amdgcn_ds_swizzle(send, 0x101F); }
    int r4; { const int keep = b3 ? r3[1] : r3[0], send = b3 ? r3[0] : r3[1]; r4 = keep + dpp_i<0x128>(send); }
    { auto q = __builtin_amdgcn_permlane16_swap((unsigned)r4, (unsigned)r4, false, false); r4 = (int)q[0] + (int)q[1]; }
    { auto q = __builtin_amdgcn_permlane32_swap((unsigned)r4, (unsigned)r4, false, false); r4 = (int)q[0] + (int)q[1]; }
    return r4; }
__device__ __forceinline__ float u_z(const UMeta8& m, int d) { return gelu_tanh((float)d * m.su * m.sh) * m.wv * m.sv; }
__device__ __forceinline__ void p11_expert_u(const Frame& F, const Args& a) {
    unsigned char* ws = a.ws; const unsigned* IDW = (const unsigned*)(ws + WS_IDW);
    const unsigned char* U8 = ws + WS_U8; const unsigned char* H8 = ws + WS_H8; const unsigned* SUVg = (const unsigned*)(ws + WS_SU); const float* SH = (const float*)(ws + WS_SH);
    unsigned* ZI = (unsigned*)(ws + WS_ZI);
    const int label = blockIdx.x & 7, rank = blockIdx.x >> 3, nblk = (F.G - label + 7) >> 3, widx = rank * NWAVES + F.wave, wstride = nblk * NWAVES;
    const int T = (M - widx + wstride - 1) / wstride;
    LAS i32x4* slot0 = (LAS i32x4*)(F.lds + F.wave * 4096);
    LAS unsigned* SUV = (LAS unsigned*)(F.lds + 32768);
    for (int i = F.tid; i < 2048; i += NTHREADS) SUV[i] = SUVg[label * 2048 + i];
    __syncthreads();
#define U_TOK(q) ((q) < T ? widx + (q) * wstride : M)
    if (F.wave >= 4) __builtin_amdgcn_s_sleep(40);
    URaw rw; UMeta8 mc, mn; u32x4 bA[16], bB[16];
#pragma unroll
    for (int s = 0; s < 16; ++s) { bA[s] = (u32x4){0u, 0u, 0u, 0u}; bB[s] = bA[s]; }
    u_prep(rw, U_TOK(0), IDW, H8, SH, F.lane);
    u_compact(rw, mc, slot0, label, SUV, F.lane);
    u_prep(rw, U_TOK(1), IDW, H8, SH, F.lane);
    u_issue16<0>(mc.idv, mc.n, bA, U8, F.lane); u_issue16<16>(mc.idv, mc.n, bB, U8, F.lane);
#pragma unroll 1
    for (int q = 0; q < T; ++q) {
        LAS i32x4* scur = slot0 + (q & 1) * 128; LAS i32x4* snxt = slot0 + ((q + 1) & 1) * 128;
        u_compact(rw, mn, snxt, label, SUV, F.lane);
        u_prep(rw, U_TOK(q + 2), IDW, H8, SH, F.lane);
        const int dA = u_dot16(bA, mc.h, F.lane);
        u_issue16<0>(mn.idv, mn.n, bA, U8, F.lane);
        int dB = 0; if (mc.n > 16) dB = u_dot16(bB, mc.h, F.lane);
        u_issue16<16>(mn.idv, mn.n, bB, U8, F.lane);
        { const float z = u_z(mc, (F.lane & 16) ? dB : dA); if (mc.tok < M && F.lane < (mc.n < 32 ? mc.n : 32)) ZI[(size_t)mc.tok * NSEL + mc.kv] = ((unsigned)mc.idv << 16) | (cvt_pk_bf16(z, 0.f) & 0xFFFFu); }
#pragma unroll 1
        for (int base = 32; base < mc.n; base += 16) {
            UMeta8 mo = mc; u_fetch(mo, scur, base, F.lane & 15, SUV); u32x4 bx[16]; u_issue16<0>(mo.idv, 16, bx, U8, F.lane);
            const int dx = u_dot16(bx, mc.h, F.lane); const float z = u_z(mo, dx);
            if (mc.tok < M && F.lane < 16 && base + F.lane < mc.n) ZI[(size_t)mc.tok * NSEL + mo.kv] = ((unsigned)mo.idv << 16) | (cvt_pk_bf16(z, 0.f) & 0xFFFFu); }
        mc = mn;
    }
#undef U_TOK
}
struct VMeta { unsigned xa, xb; int tok; };
struct VBatch { u32x4 pc[16]; };
__device__ __forceinline__ void v_load_meta(VMeta& m, int tok, const unsigned* ZI, int lane) {
    m.tok = tok; const size_t tc = (size_t)(tok < M ? tok : M - 1);
    m.xa = ZI[tc * NSEL + lane]; m.xb = ZI[tc * NSEL + 64 + lane]; }
__device__ __forceinline__ void v_issue(const VMeta& m, int cs, VBatch& b, const unsigned char* V8, int sub, int grp) {
#pragma unroll
    for (int i = 0; i < 16; ++i) { const int src = (8 * i + grp) & 63; const int id = (int)(((i < 8) ? (unsigned)__shfl((int)m.xa, src) : (unsigned)__shfl((int)m.xb, src)) >> 16);
        b.pc[i] = *(const u32x4*)(V8 + (size_t)id * D + cs * 128 + sub * 16); }
}
__device__ __forceinline__ void v_compute(const VMeta& m, int cs, const VBatch& b, bf16* out, int sub, int grp, int lane) {
    const float za = __uint_as_float(m.xa << 16), zb = __uint_as_float(m.xb << 16);
    const float cmax = wave_max(fmaxf(fabsf(za), fabsf(zb))); const float inv = cmax > 0.f ? 127.f / cmax : 0.f, sct = cmax * (1.f / 127.f);
    const int cqa = (int)__builtin_rintf(za * inv) & 255, cqb = (int)__builtin_rintf(zb * inv) & 255;
    int acc[16];
#pragma unroll
    for (int e = 0; e < 16; ++e) acc[e] = 0;
#pragma unroll
    for (int a4 = 0; a4 < 4; ++a4) {
        unsigned C = 0u;
#pragma unroll
        for (int j = 0; j < 4; ++j) { const int src = (32 * a4 + 8 * j + grp) & 63; const unsigned g = (unsigned)((a4 < 2) ? __shfl(cqa, src) : __shfl(cqb, src)); C |= g << (8 * j); }
#pragma unroll
        for (int d = 0; d < 4; ++d) { const unsigned W0 = b.pc[4 * a4][d], W1 = b.pc[4 * a4 + 1][d], W2 = b.pc[4 * a4 + 2][d], W3 = b.pc[4 * a4 + 3][d];
            const unsigned P01l = __builtin_amdgcn_perm(W1, W0, 0x05010400u), P01h = __builtin_amdgcn_perm(W1, W0, 0x07030602u);
            const unsigned P23l = __builtin_amdgcn_perm(W3, W2, 0x05010400u), P23h = __builtin_amdgcn_perm(W3, W2, 0x07030602u);
            const unsigned T0 = __builtin_amdgcn_perm(P23l, P01l, 0x05040100u), T1 = __builtin_amdgcn_perm(P23l, P01l, 0x07060302u);
            const unsigned T2 = __builtin_amdgcn_perm(P23h, P01h, 0x05040100u), T3 = __builtin_amdgcn_perm(P23h, P01h, 0x07060302u);
            acc[4 * d] = __builtin_amdgcn_sdot4((int)T0, (int)C, acc[4 * d], false); acc[4 * d + 1] = __builtin_amdgcn_sdot4((int)T1, (int)C, acc[4 * d + 1], false);
            acc[4 * d + 2] = __builtin_amdgcn_sdot4((int)T2, (int)C, acc[4 * d + 2], false); acc[4 * d + 3] = __builtin_amdgcn_sdot4((int)T3, (int)C, acc[4 * d + 3], false); } }
    const bool b3 = grp & 1;
#define V_L1(lo, hi) ((b3 ? acc[hi] : acc[lo]) + dpp_i<0x128>(b3 ? acc[lo] : acc[hi]))
    const int r1_0 = V_L1(0, 2), r1_1 = V_L1(1, 3), r1_2 = V_L1(4, 6), r1_3 = V_L1(5, 7), r1_4 = V_L1(8, 10), r1_5 = V_L1(9, 11), r1_6 = V_L1(12, 14), r1_7 = V_L1(13, 15);
#undef V_L1
#define V_SW16(x, y, o) int o; { auto q = __builtin_amdgcn_permlane16_swap((unsigned)(x), (unsigned)(y), false, false); o = (int)q[0] + (int)q[1]; }
#define V_SW32(x, y, o) int o; { auto q = __builtin_amdgcn_permlane32_swap((unsigned)(x), (unsigned)(y), false, false); o = (int)q[0] + (int)q[1]; }
    V_SW16(r1_0, r1_2, r2_0) V_SW16(r1_1, r1_3, r2_1) V_SW16(r1_4, r1_6, r2_2) V_SW16(r1_5, r1_7, r2_3)
    V_SW32(r2_0, r2_2, r3_0) V_SW32(r2_1, r2_3, r3_1)
#undef V_SW16
#undef V_SW32
    if (m.tok < M) *(unsigned*)(out + (size_t)m.tok * D + cs * 128 + sub * 16 + 2 * grp) = cvt_pk_bf16((float)r3_0 * sct, (float)r3_1 * sct);
}
__device__ __forceinline__ void p12_expert_v(const Frame& F, const Args& a) {
    unsigned char* ws = a.ws; const unsigned* ZI = (const unsigned*)(ws + WS_ZI); const unsigned char* V8 = ws + WS_V8;
    const int label = blockIdx.x & 7, rank = blockIdx.x >> 3, nblk = (F.G - label + 7) >> 3, widx = rank * NWAVES + F.wave, wstride = nblk * NWAVES;
    const int sub = F.lane & 7, grp = F.lane >> 3;
    const int T = (M - widx + wstride - 1) / wstride, NQ = (T + 1) & ~1;
#define V_TOK(q) ((q) < T ? widx + (q) * wstride : M)
    if (F.wave >= 4) __builtin_amdgcn_s_sleep(40);
    VMeta mc, mn, mf; VBatch bA, bB;
    v_load_meta(mc, V_TOK(0), ZI, F.lane); v_load_meta(mn, V_TOK(1), ZI, F.lane);
    v_issue(mc, label, bA, V8, sub, grp);
#pragma unroll 1
    for (int q = 0; q < NQ; q += 2) {
        v_issue(mn, label, bB, V8, sub, grp); v_load_meta(mf, V_TOK(q + 2), ZI, F.lane); v_compute(mc, label, bA, (bf16*)(a.ws + WS_FFN), sub, grp, F.lane); mc = mn; mn = mf;
        v_issue(mn, label, bA, V8, sub, grp); v_load_meta(mf, V_TOK(q + 3), ZI, F.lane); v_compute(mc, label, bB, (bf16*)(a.ws + WS_FFN), sub, grp, F.lane); mc = mn; mn = mf;
    }
#undef V_TOK
}
__device__ __forceinline__ void p13_final(const Frame& F, const Args& a) {
    const bf16* H1 = (const bf16*)(a.ws + WS_H1); const bf16* FFN = (const bf16*)(a.ws + WS_FFN);
    u32x2 nh[4], nf[4];
#pragma unroll
    for (int j = 0; j < 4; ++j) { const size_t t0 = (size_t)(F.gw < M ? F.gw : 0); nh[j] = *((const u32x2*)(H1 + t0 * D) + F.lane + 64 * j); nf[j] = *((const u32x2*)(FFN + t0 * D) + F.lane + 64 * j); }
#pragma unroll 1
    for (int tok = F.gw; tok < M; tok += F.NGW) {
        f32x4 y[4]; const size_t tn = (size_t)(tok + F.NGW < M ? tok + F.NGW : tok);
#pragma unroll
        for (int j = 0; j < 4; ++j) { const u32x2 w = nh[j], f = nf[j];
            y[j].x = ALPHA * bf_lo(w.x) + bf_lo(f.x); y[j].y = ALPHA * bf_hi(w.x) + bf_hi(f.x); y[j].z = ALPHA * bf_lo(w.y) + bf_lo(f.y); y[j].w = ALPHA * bf_hi(w.y) + bf_hi(f.y);
            nh[j] = *((const u32x2*)(H1 + tn * D) + F.lane + 64 * j); nf[j] = *((const u32x2*)(FFN + tn * D) + F.lane + 64 * j); }
        ln_vals(y, a.in[I_LN2G], a.in[I_LN2B], F.lane);
#pragma unroll
        for (int j = 0; j < 4; ++j) *((f32x4*)(a.out + (size_t)tok * D) + F.lane + 64 * j) = y[j];
    }
}

__device__ __forceinline__ void g1a_inproj(const Frame& F, const Args& a) { unsigned char* ws = a.ws;
    const bf16* WT = (const bf16*)(ws + WS_WINT); unsigned char* WG8 = ws + WS_WG8; float* SB = (float*)(ws + WS_SB);
    for (int r = F.gw; r < NPROJ; r += F.NGW) { f32x4 v[4];
#pragma unroll
        for (int j = 0; j < 4; ++j) { const u32x2 w = *((const u32x2*)(WT + (size_t)r * 1024) + F.lane + 64 * j); v[j] = (f32x4){bf_lo(w.x), bf_hi(w.x), bf_lo(w.y), bf_hi(w.y)}; }
        const float am = fmaxf(absmax4(v), 1e-20f), inv = 127.f / am;
#pragma unroll
        for (int j = 0; j < 4; ++j) *((unsigned*)(WG8 + (size_t)r * 1024) + F.lane + 64 * j) = pack_i8x4(v[j], inv);
        if (F.lane == 0) SB[r] = am * (1.f / 127.f); } }
__device__ __forceinline__ void g1b_inproj(const Frame& F, const Args& a) { unsigned char* ws = a.ws; pg8::StaticOrder S;
    pg8::Gemm g{(const char*)(ws + WS_H0Q), (const char*)(ws + WS_WG8), 512u, 512u, 8, 256, 18, -1}; S.init(256, 18, F.G, blockIdx.x);
    pg8::EpiInProjSig8 E{(bf16*)(ws + WS_XR), (bf16*)(ws + WS_ACAT), (bf16*)(ws + WS_XP), (bf16*)(ws + WS_GL), (const float*)(ws + WS_SA), (const float*)(ws + WS_SB)};
    pg8::gemm_phase<pg8::EpiInProjSig8, true, true, -1, true>(F.lds, g, S, E); }
__device__ __forceinline__ void g3_gate(const Frame& F, const Args& a) { unsigned char* ws = a.ws; pg8::StaticOrder S;
    pg8::Gemm g{(const char*)(ws + WS_XC), (const char*)(ws + WS_GATET), 1024u, 256u, 4, 256, 8, 1}; S.init(256, 8, F.G, blockIdx.x);
    pg8::EpiGate E{(const bf16*)(ws + WS_XC), a.in[I_BRG], a.in[I_BIG], (const float*)(ws + WS_LS8), (bf16*)(ws + WS_LOGA), (bf16*)(ws + WS_BB)};
    pg8::gemm_phase<pg8::EpiGate, true, true>(F.lds, g, S, E); }
__device__ __forceinline__ void g6_merge(const Frame& F, const Args& a) { unsigned char* ws = a.ws; pg8::StaticOrder S; S.init(256, 4, F.G, blockIdx.x);
    pg8::Gemm g{(const char*)(ws + WS_ACAT), (const char*)(ws + WS_BCAT), 1536u, 1536u, 24, 256, 4, -1};
    pg8::EpiMerge E{(const bf16*)(ws + WS_GL), (bf16*)(ws + WS_MERGED)};
    pg8::gemm_phase<pg8::EpiMerge, true, true, 8>(F.lds, g, S, E); }
__device__ __forceinline__ void g7_out(const Frame& F, const Args& a) { unsigned char* ws = a.ws; pg8::StaticOrder S;
    pg8::Gemm g{(const char*)(ws + WS_MERGED), (const char*)(ws + WS_WOUTT), 1024u, 1024u, 16, 256, 4, -1}; S.init(256, 4, F.G, blockIdx.x);
    pg8::EpiOut E{(const bf16*)(ws + WS_H0), (bf16*)(ws + WS_V1)};
    pg8::gemm_phase<pg8::EpiOut, true, true>(F.lds, g, S, E); }
__device__ __forceinline__ void g9_q(const Frame& F, const Args& a) { unsigned char* ws = a.ws; pg8::StaticOrder S;
    pg8::Gemm g{(const char*)(ws + WS_H8), (const char*)(ws + WS_WQ8), 512u, 512u, 8, 256, 8, -1}; S.init(256, 8, F.G, blockIdx.x);
    pg8::EpiQ8 E{(bf16*)(ws + WS_Q), (const float*)(ws + WS_SH), (const float*)(ws + WS_SQ)};
    pg8::gemm_phase<pg8::EpiQ8, true, true, -1, true>(F.lds, g, S, E); }

__global__ void __launch_bounds__(NTHREADS, 2) fwd_kernel(Args a) {
    extern __shared__ __attribute__((aligned(16))) unsigned char lds_raw[];
    Frame F; F.lds = (LAS unsigned char*)lds_raw; F.tid = threadIdx.x; F.lane = F.tid & 63; F.wave = __builtin_amdgcn_readfirstlane(F.tid >> 6); F.G = gridDim.x;
    F.gw = blockIdx.x * NWAVES + F.wave; F.NGW = F.G * NWAVES;
    unsigned char* ws = a.ws;
    const int lo = a.ph_lo, hi = a.ph_hi;
    volatile LAS unsigned* misc = (volatile LAS unsigned*)(F.lds + 131072);
    if (F.tid < 4) misc[F.tid] = 0u;
    __syncthreads();
    if (a.ph_lo < 0) cg::this_grid().sync();
    XcdBarrier xbar = xcd_barrier_post((unsigned*)(ws + WS_CTL) + 4096, misc);
#ifndef REP_MASK
#define REP_MASK 0
#endif
#define IN(k) (lo <= (k) && (k) < hi)
#define REP(k) ((REP_MASK >> (k)) & 1)
#define SEAM(k) do { if (IN(k) && IN((k) + 1)) { xcd_barrier(xbar); } } while (0)
    if (IN(0)) { p0_prologue(F, a); if (REP(0)) p0_prologue(F, a); } SEAM(0);
    if (IN(1)) { g1a_inproj(F, a); xcd_barrier(xbar); g1b_inproj(F, a); } SEAM(1);
    if (IN(2)) { p2_convpool(F, a); if (REP(2)) p2_convpool(F, a); } SEAM(2);
    if (IN(3)) { g3_gate(F, a); if (REP(3)) g3_gate(F, a); } SEAM(3);
    if (IN(4)) { p4_scan_agg(F, a); if (REP(4)) p4_scan_agg(F, a); } SEAM(4);
    if (IN(5)) { p5_scan_apply(F, a); if (REP(5)) p5_scan_apply(F, a); } SEAM(5);
    if (IN(6)) { g6_merge(F, a); if (REP(6)) g6_merge(F, a); } SEAM(6);
    if (IN(7)) { g7_out(F, a); if (REP(7)) g7_out(F, a); } SEAM(7);
    if (IN(8)) { p8_ln1(F, a); if (REP(8)) p8_ln1(F, a); } SEAM(8);
    if (IN(9)) { g9_q(F, a); if (REP(9)) g9_q(F, a); } SEAM(9);
    if (IN(10)) { p10_retrieve(F, a); if (REP(10)) p10_retrieve(F, a); } SEAM(10);
    if (IN(11)) { p11_expert_u(F, a); if (REP(11)) p11_expert_u(F, a); } SEAM(11);
    if (IN(12)) { p12_expert_v(F, a); if (REP(12)) p12_expert_v(F, a); } SEAM(12);
    if (IN(13)) { p13_final(F, a); }
#undef IN
#undef SEAM
}

extern "C" void kernel_launch(void* const* d_in, const int* in_sizes, int n_in, void* d_out, int out_size, void* d_ws, size_t ws_size, hipStream_t stream) {
    static int grid = 0;
    if (grid == 0) {
        if (n_in != 25 || in_sizes[0] != M * D || out_size != M * D || ws_size < WS_END) { fprintf(stderr, "kernel_launch: unexpected shapes: n_in %d in0 %d out %d ws %zu\n", n_in, n_in > 0 ? in_sizes[0] : -1, out_size, ws_size); grid = -1; return; }
        int dev = 0, cus = 0, per_cu = 0;
        hipGetDevice(&dev); hipDeviceGetAttribute(&cus, hipDeviceAttributeMultiprocessorCount, dev);
        if (hipFuncSetAttribute((const void*)fwd_kernel, hipFuncAttributeMaxDynamicSharedMemorySize, LDS_BYTES) != hipSuccess) { fprintf(stderr, "kernel_launch: hipFuncSetAttribute failed\n"); grid = -1; return; }
        if (hipOccupancyMaxActiveBlocksPerMultiprocessor(&per_cu, (const void*)fwd_kernel, NTHREADS, LDS_BYTES) != hipSuccess || per_cu < 1) { fprintf(stderr, "kernel_launch: occupancy query says %d\n", per_cu); per_cu = 1; }
        (void)hipGetLastError();
        grid = cus;
        fprintf(stderr, "kernel_launch: grid %d (occupancy query %d per CU)\n", grid, per_cu);
    }
    if (grid < 0) return;
    if (hipMemsetAsync((char*)d_ws + WS_CTL, 0, 65536, stream) != hipSuccess) { fprintf(stderr, "kernel_launch: hipMemsetAsync failed\n"); return; }
    Args a{};
    for (int i = 0; i < 25; ++i) a.in[i] = (const float*)d_in[i];
    a.out = (float*)d_out; a.ws = (unsigned char*)d_ws;
#if MK_ONE_LAUNCH
    a.ph_lo = 0; a.ph_hi = NPHASES;
    { void* args[] = {&a}; hipError_t e = hipLaunchCooperativeKernel((const void*)fwd_kernel, dim3(grid), dim3(NTHREADS), args, LDS_BYTES, stream);
      if (e != hipSuccess) fprintf(stderr, "kernel_launch: cooperative launch failed: %s\n", hipGetErrorString(e)); }
#else
    for (int p = 0; p < NPHASES; ++p) { a.ph_lo = p; a.ph_hi = p + 1; void* args[] = {&a};
        hipError_t e = hipLaunchCooperativeKernel((const void*)fwd_kernel, dim3(grid), dim3(NTHREADS), args, LDS_BYTES, stream);
        if (e != hipSuccess) { fprintf(stderr, "kernel_launch: launch %d failed: %s\n", p, hipGetErrorString(e)); break; } }
#endif
}
```

```cpp
#include <hip/hip_runtime.h>
#include <hip/hip_cooperative_groups.h>
#include <cstdio>
#include <cstdint>
namespace cg = cooperative_groups;

#ifndef MK_ONE_LAUNCH
#define MK_ONE_LAUNCH 1
#endif

#define LAS __attribute__((address_space(3)))
typedef unsigned short bf16;
typedef unsigned u32x4 __attribute__((ext_vector_type(4)));
typedef unsigned u32x2 __attribute__((ext_vector_type(2)));
typedef float f32x4 __attribute__((ext_vector_type(4)));
typedef float f32x2 __attribute__((ext_vector_type(2)));
typedef short bf16x8 __attribute__((ext_vector_type(8)));

constexpr int NB = 8, SEQ = 8192, D = 1024, M = NB * SEQ, NMETA = 16, NPROJ = 4608, DPOOL = 512;
constexpr int PH = 8, PKEYS = 128, NSEL = 128;
constexpr float ALPHA = 1.189207115002721f, LN_EPS = 1e-5f, LOG2E = 1.4426950408889634f;
constexpr int NWAVES = 8, NTHREADS = 512;
constexpr int LDS_BYTES = 131072 + 1024 + 16384;

constexpr size_t MiB = 1u << 20;
constexpr size_t WS_CTL = 0;
constexpr size_t WS_PROJM = 1 * MiB;
constexpr size_t WS_HMETA = 1 * MiB + 128 * 1024;
constexpr size_t WS_LS8 = 1 * MiB + 192 * 1024;
constexpr size_t WS_AGG = 2 * MiB;
constexpr size_t WS_SUBAGG = 4 * MiB;
constexpr size_t WS_WCOMBF = 12 * MiB;
constexpr size_t WS_KEYS = 14 * MiB;
constexpr size_t WS_GATET = 15 * MiB;
constexpr size_t WS_WINT = 16 * MiB;
constexpr size_t WS_BCAT = 25 * MiB;
constexpr size_t WS_WOUTT = 28 * MiB;
constexpr size_t WS_WQT = 30 * MiB;
constexpr size_t WS_H0 = 34 * MiB;
constexpr size_t WS_ACAT = 162 * MiB;
constexpr int ACAT_LD = 1536;
constexpr size_t WS_H1 = WS_ACAT;
constexpr size_t WS_GL = 354 * MiB;
constexpr size_t WS_V1 = WS_GL;
constexpr size_t WS_FFN = WS_GL + 128 * MiB;
constexpr size_t WS_XC = 610 * MiB;
constexpr size_t WS_XR = 738 * MiB;
constexpr size_t WS_LOGA = WS_XR;
constexpr size_t WS_MERGED = WS_XR;
constexpr size_t WS_XP = 866 * MiB;
constexpr size_t WS_BB = WS_XP;
constexpr size_t WS_Q = 546 * MiB;
constexpr size_t WS_IDW = 802 * MiB;
constexpr size_t WS_U8 = 866 * MiB;
constexpr size_t WS_V8 = 882 * MiB;
constexpr size_t WS_H8 = 898 * MiB;
constexpr size_t WS_ZI = 962 * MiB;
constexpr size_t WS_SU = 994 * MiB;
constexpr size_t WS_SH = 994 * MiB + 131072;
constexpr size_t WS_H0Q = 610 * MiB;
constexpr size_t WS_SA = 995 * MiB;
constexpr size_t WS_WG8 = 996 * MiB;
constexpr size_t WS_SB = 1001 * MiB;
constexpr size_t WS_WQ8 = 1002 * MiB;
constexpr size_t WS_SQ = 1004 * MiB;
constexpr size_t WS_END = 1024 * MiB;

typedef __bf16 bf16x2_cv __attribute__((ext_vector_type(2)));
__device__ __forceinline__ unsigned cvt_pk_bf16(float lo, float hi) { const f32x2 v = {lo, hi}; return __builtin_bit_cast(unsigned, __builtin_convertvector(v, bf16x2_cv)); }
__device__ __forceinline__ float bf_lo(unsigned u) { return __uint_as_float(u << 16); }
__device__ __forceinline__ float bf_hi(unsigned u) { return __uint_as_float(u & 0xffff0000u); }
__device__ __forceinline__ float fast_exp(float x) { return __builtin_amdgcn_exp2f(x * LOG2E); }
__device__ __forceinline__ float sigmoidf_(float x) { return __builtin_amdgcn_rcpf(1.f + fast_exp(-x)); }
__device__ __forceinline__ float gelu_tanh(float x) { const float u2 = 1.5957691216057308f * x * (1.f + 0.044715f * x * x); return x * __builtin_amdgcn_rcpf(1.f + fast_exp(-u2)); }
template <int CTRL> __device__ __forceinline__ float dpp_f(float v) { return __builtin_bit_cast(float, __builtin_amdgcn_update_dpp(0, __builtin_bit_cast(int, v), CTRL, 0xf, 0xf, true)); }
__device__ __forceinline__ float wave_sum(float v) {
    v += dpp_f<0xB1>(v); v += dpp_f<0x4E>(v); v += dpp_f<0x141>(v); v += dpp_f<0x140>(v);
    { auto q = __builtin_amdgcn_permlane16_swap(__float_as_uint(v), __float_as_uint(v), false, false); v = __uint_as_float(q[0]) + __uint_as_float(q[1]); }
    { auto q = __builtin_amdgcn_permlane32_swap(__float_as_uint(v), __float_as_uint(v), false, false); v = __uint_as_float(q[0]) + __uint_as_float(q[1]); }
    return v; }
__device__ __forceinline__ float wave_max(float v) {
    v = fmaxf(v, dpp_f<0xB1>(v)); v = fmaxf(v, dpp_f<0x4E>(v)); v = fmaxf(v, dpp_f<0x141>(v)); v = fmaxf(v, dpp_f<0x140>(v));
    { auto q = __builtin_amdgcn_permlane16_swap(__float_as_uint(v), __float_as_uint(v), false, false); v = fmaxf(__uint_as_float(q[0]), __uint_as_float(q[1])); }
    { auto q = __builtin_amdgcn_permlane32_swap(__float_as_uint(v), __float_as_uint(v), false, false); v = fmaxf(__uint_as_float(q[0]), __uint_as_float(q[1])); }
    return v; }
__device__ __forceinline__ int wave_min_i(int v) {
#pragma unroll
    for (int o = 1; o < 64; o <<= 1) v = min(v, __shfl_xor(v, o));
    return v; }
__device__ __forceinline__ float wave_sum_u(float v) {
    v += dpp_f<0xB1>(v); v += dpp_f<0x4E>(v); v += dpp_f<0x141>(v); v += dpp_f<0x140>(v);
    return (__builtin_bit_cast(float, __builtin_amdgcn_readlane(__builtin_bit_cast(int, v), 0)) + __builtin_bit_cast(float, __builtin_amdgcn_readlane(__builtin_bit_cast(int, v), 16))) +
           (__builtin_bit_cast(float, __builtin_amdgcn_readlane(__builtin_bit_cast(int, v), 32)) + __builtin_bit_cast(float, __builtin_amdgcn_readlane(__builtin_bit_cast(int, v), 48))); }
typedef __bf16 bf16x2_t __attribute__((ext_vector_type(2)));
__device__ __forceinline__ float dot2bf(unsigned a, unsigned b, float c) { return __builtin_amdgcn_fdot2_f32_bf16(__builtin_bit_cast(bf16x2_t, a), __builtin_bit_cast(bf16x2_t, b), c, false); }
__device__ __forceinline__ float dot8bf(const u32x4 a, const u32x4 b, float c) { c = dot2bf(a.x, b.x, c); c = dot2bf(a.y, b.y, c); c = dot2bf(a.z, b.z, c); return dot2bf(a.w, b.w, c); }
#define LDS_WAIT() asm volatile("s_waitcnt lgkmcnt(0)" ::: "memory")
__device__ __forceinline__ void unpack8(const u32x4 w, float (&f)[8]) {
    f[0] = bf_lo(w.x); f[1] = bf_hi(w.x); f[2] = bf_lo(w.y); f[3] = bf_hi(w.y); f[4] = bf_lo(w.z); f[5] = bf_hi(w.z); f[6] = bf_lo(w.w); f[7] = bf_hi(w.w); }
__device__ __forceinline__ u32x4 pack8(const float (&f)[8]) { u32x4 w; w.x = cvt_pk_bf16(f[0], f[1]); w.y = cvt_pk_bf16(f[2], f[3]); w.z = cvt_pk_bf16(f[4], f[5]); w.w = cvt_pk_bf16(f[6], f[7]); return w; }

namespace pg8 {
constexpr int TR_BASE = 131072 + 1024;
constexpr int BM = 256, BK = 64, HALF = 128, HTB = HALF * BK * 2, STAGE_BYTES = 8 * HTB, NXCD = 8, WGM = 8;
__host__ __device__ __forceinline__ int lds_byte(int r, int c) { const int st = (r >> 4) * 2 + (c >> 5), rr = r & 15, cc = c & 31, ob = rr * 64 + cc * 2; return st * 1024 + (ob ^ (((ob >> 9) & 1) << 5)); }
__host__ __device__ __forceinline__ void stage_rc(int b, int& R, int& C) { const int st = b / 1024, sb = b % 1024, swz = sb ^ (((sb >> 9) & 1) << 5); R = (st >> 1) * 16 + swz / 64; C = (st & 1) * 32 + (swz % 64) / 2; }
__host__ __device__ __forceinline__ int perm32(int rho) { const int n = rho >> 4, i = rho & 15; return 8 * (i >> 2) + 4 * n + (i & 3); }

struct Unit { int pm, pn; };
struct Gemm { const char* A; const char* B; unsigned lda, ldb; int nt, nM, nN, a_shift; int b_gap_at = 1 << 30, b_gap_rows = 0; };
__device__ __forceinline__ const char* a_tile(const Gemm& g, const Unit& u) { size_t off = (size_t)u.pm * 256 * g.lda; if (g.a_shift >= 0) off += (size_t)(u.pn >> g.a_shift) * 256; return g.A + off * 2; }
__device__ __forceinline__ const char* b_tile(const Gemm& g, const Unit& u) { return g.B + (size_t)(u.pn * 256 + (u.pn >= g.b_gap_at ? g.b_gap_rows : 0)) * g.ldb * 2; }

struct StaticOrder {
    int nM, nN, nwg, G, c;
    __device__ void init(int nM_, int nN_, int G_, int c_) { nM = nM_; nN = nN_; nwg = nM * nN; G = G_; c = c_; }
    __device__ bool next(int i, Unit& u) const {
        const long L = (long)i * G + c; if (L >= nwg) return false;
        int wgid = (int)L; { const int q = nwg / NXCD, r = nwg % NXCD, xcd = wgid % NXCD, off = wgid / NXCD; wgid = (xcd < r ? xcd * (q + 1) : r * (q + 1) + (xcd - r) * q) + off; }
        const int nig = WGM * nN, gid = wgid / nig, fm = gid * WGM, gsz = (nM - fm) < WGM ? (nM - fm) : WGM;
        u.pm = fm + ((wgid % nig) % gsz); u.pn = (wgid % nig) / gsz; return true;
    }
};

typedef int i32x4_t __attribute__((ext_vector_type(4)));
template <bool I8> __device__ __forceinline__ f32x4 mma16(const bf16x8 b, const bf16x8 a, const f32x4 c) {
    if constexpr (I8) return __builtin_bit_cast(f32x4, __builtin_amdgcn_mfma_i32_16x16x64_i8(__builtin_bit_cast(i32x4_t, b), __builtin_bit_cast(i32x4_t, a), __builtin_bit_cast(i32x4_t, c), 0, 0, 0));
    else return __builtin_amdgcn_mfma_f32_16x16x32_bf16(b, a, c, 0, 0, 0);
}
template <class Epi, bool ALIGN_EPI, bool SP2, int HOOK_T = -1, bool I8 = false>
__device__ __forceinline__ void gemm_phase(LAS unsigned char* lds, const Gemm g, const StaticOrder& S, const Epi& E) {
    const int tid = threadIdx.x, wid = __builtin_amdgcn_readfirstlane(tid >> 6), lane = tid & 63, wr = wid >> 2, wc = wid & 3, fr = lane & 15, fq = lane >> 4;
    const int nt = g.nt;
    unsigned voffA[2], voffB[2];
#pragma unroll
    for (int i = 0; i < 2; ++i) { int R, C; stage_rc(tid * 16 + i * 8192, R, C); const int Rb = (R & ~31) + perm32(R & 31);
        voffA[i] = (unsigned)(R * g.lda + C) * 2u; voffB[i] = (unsigned)(Rb * g.ldb + C) * 2u; }
    const size_t kstep = (size_t)(BK * 2);
    const size_t hstepA = (size_t)HALF * g.lda * 2, hstepB = (size_t)HALF * g.ldb * 2;
    const unsigned ldsw = (unsigned)wid * 1024u;
    const int aoff = lds_byte(wr * 64 + fr, fq * 8), boff = lds_byte(wc * 32 + fr, fq * 8);
#define PG8_SA(b, h) (((b) * 2 + (h)) * HTB)
#define PG8_SB(b, h) ((4 + (b) * 2 + (h)) * HTB)
#define PG8_STAGE(bufoff, gbase, voff) do { _Pragma("unroll") for (int _i = 0; _i < 2; ++_i) \
        __builtin_amdgcn_global_load_lds((const unsigned*)((const char*)(gbase) + (voff)[_i]), (LAS unsigned*)(lds + (bufoff) + ldsw + _i * 8192), 16, 0, 0); } while (0)
#define PG8_LDA(dst, b, h) do { _Pragma("unroll") for (int m = 0; m < 4; ++m) _Pragma("unroll") for (int k = 0; k < 2; ++k) dst[m][k] = *(const LAS bf16x8*)(lds + PG8_SA(b, h) + aoff + m * 2048 + k * 1024); } while (0)
#define PG8_LDB(dst, b, h) do { _Pragma("unroll") for (int n = 0; n < 2; ++n) _Pragma("unroll") for (int k = 0; k < 2; ++k) dst[n][k] = *(const LAS bf16x8*)(lds + PG8_SB(b, h) + boff + n * 2048 + k * 1024); } while (0)
#define PG8_MMA(ai, bj, At, Bt) do { __builtin_amdgcn_s_setprio(1); _Pragma("unroll") for (int k = 0; k < 2; ++k) _Pragma("unroll") for (int m = 0; m < 4; ++m) _Pragma("unroll") for (int n = 0; n < 2; ++n) \
        acc[ai][bj][m][n] = mma16<I8>(Bt[n][k], At[m][k], acc[ai][bj][m][n]); __builtin_amdgcn_s_setprio(0); } while (0)
#define PG8_WAIT_V(n) asm volatile("s_waitcnt vmcnt(" #n ")" ::: "memory")
#define PG8_WAIT_L(n) asm volatile("s_waitcnt lgkmcnt(" #n ")" ::: "memory")
#define PG8_BAR __builtin_amdgcn_s_barrier()
#define PG8_SCHED __builtin_amdgcn_sched_barrier(0)
    Unit cur, nxt; int ui = 0;
    if (!S.next(0, cur)) return;
    f32x4 acc[2][2][4][2];
#pragma unroll
    for (int a = 0; a < 2; ++a)
#pragma unroll
        for (int b = 0; b < 2; ++b)
#pragma unroll
            for (int m = 0; m < 4; ++m)
#pragma unroll
                for (int n = 0; n < 2; ++n) acc[a][b][m][n] = (f32x4){0.f, 0.f, 0.f, 0.f};
    bf16x8 At[4][2], B0[2][2], B1[2][2];
    const char* cA = a_tile(g, cur); const char* cB = b_tile(g, cur);
    if constexpr (SP2) {
        PG8_STAGE(PG8_SB(0, 0), cB, voffB); PG8_STAGE(PG8_SB(0, 1), cB + hstepB, voffB); PG8_STAGE(PG8_SA(0, 0), cA, voffA); PG8_STAGE(PG8_SA(0, 1), cA + hstepA, voffA);
        if (wr == 1) PG8_BAR;
        PG8_WAIT_V(2); PG8_BAR;
        PG8_STAGE(PG8_SB(1, 0), cB + kstep, voffB); PG8_STAGE(PG8_SA(1, 0), cA + kstep, voffA); PG8_STAGE(PG8_SB(1, 1), cB + hstepB + kstep, voffB);
        PG8_WAIT_V(6); PG8_BAR;
    } else {
        PG8_STAGE(PG8_SB(0, 0), cB, voffB); PG8_STAGE(PG8_SA(0, 0), cA, voffA); PG8_STAGE(PG8_SB(0, 1), cB + hstepB, voffB); PG8_STAGE(PG8_SA(0, 1), cA + hstepA, voffA);
        if (wr == 1) PG8_BAR;
        PG8_WAIT_V(4); PG8_BAR;
        PG8_STAGE(PG8_SB(1, 0), cB + kstep, voffB); PG8_STAGE(PG8_SA(1, 0), cA + kstep, voffA); PG8_STAGE(PG8_SB(1, 1), cB + hstepB + kstep, voffB);
        PG8_WAIT_V(6); PG8_BAR;
    }
    for (;;) {
        const bool has_next = S.next(ui + 1, nxt);
        const char* nA = has_next ? a_tile(g, nxt) : cA; const char* nB = has_next ? b_tile(g, nxt) : cB;
        for (int t = 0; t < nt; t += 2) {
            if constexpr (HOOK_T >= 0) { if (t == HOOK_T) E.mid(acc, cur, wr, wc, fr, fq); }
            const bool last = (t == nt - 2);
            const char* a1 = cA + (size_t)(t + 1) * kstep;
            const char* a2 = last ? nA : cA + (size_t)(t + 2) * kstep; const char* b2 = last ? nB : cB + (size_t)(t + 2) * kstep;
            const char* a3 = a2 + kstep; const char* b3 = b2 + kstep;
            if constexpr (SP2) {
            PG8_LDB(B0, 0, 0); PG8_LDB(B1, 0, 1); PG8_SCHED; PG8_LDA(At, 0, 0); PG8_STAGE(PG8_SA(1, 1), a1 + hstepA, voffA);
            PG8_WAIT_V(8); PG8_WAIT_L(0); PG8_BAR; PG8_MMA(0, 0, At, B0); PG8_MMA(0, 1, At, B1); PG8_BAR; PG8_SCHED;
            PG8_LDA(At, 0, 1); PG8_STAGE(PG8_SB(0, 0), b2, voffB); PG8_STAGE(PG8_SB(0, 1), b2 + hstepB, voffB); PG8_STAGE(PG8_SA(0, 0), a2, voffA);
            PG8_WAIT_V(8); PG8_WAIT_L(0); PG8_BAR; PG8_MMA(1, 0, At, B0); PG8_MMA(1, 1, At, B1); PG8_BAR; PG8_SCHED;
            PG8_LDB(B0, 1, 0); PG8_LDB(B1, 1, 1); PG8_SCHED; PG8_LDA(At, 1, 0); PG8_STAGE(PG8_SA(0, 1), a2 + hstepA, voffA);
            PG8_WAIT_V(8); PG8_WAIT_L(0); PG8_BAR; PG8_MMA(0, 0, At, B0); PG8_MMA(0, 1, At, B1); PG8_BAR; PG8_SCHED;
            PG8_LDA(At, 1, 1); PG8_STAGE(PG8_SB(1, 0), b3, voffB); PG8_STAGE(PG8_SB(1, 1), b3 + hstepB, voffB); PG8_STAGE(PG8_SA(1, 0), a3, voffA);
            PG8_WAIT_V(8); PG8_WAIT_L(0); PG8_BAR; PG8_MMA(1, 0, At, B0); PG8_MMA(1, 1, At, B1); PG8_BAR; PG8_SCHED;
            } else {
            PG8_LDB(B0, 0, 0); PG8_SCHED; PG8_LDA(At, 0, 0); PG8_STAGE(PG8_SA(1, 1), a1 + hstepA, voffA);
            PG8_WAIT_L(8); PG8_BAR; PG8_WAIT_L(0); PG8_MMA(0, 0, At, B0); PG8_BAR; PG8_SCHED;
            PG8_LDB(B1, 0, 1); PG8_STAGE(PG8_SB(0, 0), b2, voffB);
            PG8_BAR; PG8_WAIT_L(0); PG8_MMA(0, 1, At, B1); PG8_BAR;
            PG8_LDA(At, 0, 1); PG8_STAGE(PG8_SA(0, 0), a2, voffA);
            PG8_BAR; PG8_WAIT_L(0); PG8_MMA(1, 0, At, B0); PG8_BAR; PG8_SCHED;
            PG8_STAGE(PG8_SB(0, 1), b2 + hstepB, voffB);
            PG8_WAIT_V(6); PG8_BAR; PG8_MMA(1, 1, At, B1); PG8_BAR;
            PG8_LDB(B0, 1, 0); PG8_SCHED; PG8_LDA(At, 1, 0); PG8_STAGE(PG8_SA(0, 1), a2 + hstepA, voffA);
            PG8_WAIT_L(8); PG8_BAR; PG8_WAIT_L(0); PG8_MMA(0, 0, At, B0); PG8_BAR; PG8_SCHED;
            PG8_LDB(B1, 1, 1); PG8_STAGE(PG8_SB(1, 0), b3, voffB);
            PG8_BAR; PG8_WAIT_L(0); PG8_MMA(0, 1, At, B1); PG8_BAR;
            PG8_LDA(At, 1, 1); PG8_STAGE(PG8_SA(1, 0), a3, voffA);
            PG8_BAR; PG8_WAIT_L(0); PG8_MMA(1, 0, At, B0); PG8_BAR; PG8_SCHED;
            PG8_STAGE(PG8_SB(1, 1), b3 + hstepB, voffB);
            PG8_WAIT_V(6); PG8_BAR; PG8_MMA(1, 1, At, B1); PG8_BAR;
            }
        }
        if constexpr (ALIGN_EPI) { if (wr == 0) PG8_BAR; }
        E(acc, cur, wr, wc, fr, fq, lds + TR_BASE + wid * 2048);
        if (!has_next) break;
#pragma unroll
        for (int a = 0; a < 2; ++a)
#pragma unroll
            for (int b = 0; b < 2; ++b)
#pragma unroll
                for (int m = 0; m < 4; ++m)
#pragma unroll
                    for (int n = 0; n < 2; ++n) acc[a][b][m][n] = (f32x4){0.f, 0.f, 0.f, 0.f};
        cur = nxt; cA = nA; cB = nB; ++ui;
        if constexpr (ALIGN_EPI) { if (wr == 1) PG8_BAR; }
    }
    PG8_WAIT_V(0);
    if constexpr (!ALIGN_EPI) { if (wr == 0) PG8_BAR; }
    PG8_BAR;
#undef PG8_SA
#undef PG8_SB
#undef PG8_STAGE
#undef PG8_LDA
#undef PG8_LDB
#undef PG8_MMA
#undef PG8_WAIT_V
#undef PG8_WAIT_L
#undef PG8_BAR
#undef PG8_SCHED
}

__device__ __forceinline__ void tr_store(LAS unsigned char* trb, int slot, int fr, int fq, bf16* blk, size_t ld, const u32x4 w) {
    const int lane = fq * 16 + fr;
    *(LAS u32x4*)(trb + slot * 1024 + fr * 64 + (((fq ^ (fr >> 1)) & 3) << 4)) = w;
    asm volatile("" ::: "memory");
    const u32x4 t = *(const LAS u32x4*)(trb + slot * 1024 + lane * 16);
    *(u32x4*)(blk + (size_t)(lane >> 2) * ld + 8 * ((lane & 3) ^ ((lane >> 3) & 3))) = t;
}
#define EPI_FOR_ROWS  _Pragma("unroll") for (int ai = 0; ai < 2; ++ai) _Pragma("unroll") for (int m = 0; m < 4; ++m)
#define EPI_ROW (u.pm * 256 + ai * 128 + wr * 64 + m * 16 + fr)
#define EPI_ROW0 (u.pm * 256 + ai * 128 + wr * 64 + m * 16)
#define EPI_VALS(bj) const float v[8] = {acc[ai][bj][m][0][0], acc[ai][bj][m][0][1], acc[ai][bj][m][0][2], acc[ai][bj][m][0][3], acc[ai][bj][m][1][0], acc[ai][bj][m][1][1], acc[ai][bj][m][1][2], acc[ai][bj][m][1][3]}

struct EpiInProj {
    bf16 *XR, *XP;
    __device__ __forceinline__ void operator()(const f32x4 (&acc)[2][2][4][2], const Unit& u, int wr, int wc, int fr, int fq) const {
        bf16* base; int ld, ct;
        if (u.pn < 4) { base = XR; ld = 1024; ct = u.pn; } else { base = XP; ld = 512; ct = u.pn - 4; }
        EPI_FOR_ROWS { bf16* rowp = base + (size_t)EPI_ROW * ld + ct * 256 + wc * 32 + 8 * fq;
#pragma unroll
            for (int bj = 0; bj < 2; ++bj) { EPI_VALS(bj); *(u32x4*)(rowp + bj * 128) = pack8(v); } }
    }
};
struct EpiInProjSig {
    bf16* GL;
    __device__ __forceinline__ void operator()(const f32x4 (&acc)[2][2][4][2], const Unit& u, int wr, int wc, int fr, int fq) const {
        EPI_FOR_ROWS { bf16* rowp = GL + (size_t)EPI_ROW * 2048 + u.pn * 256 + wc * 32 + 8 * fq;
#pragma unroll
            for (int bj = 0; bj < 2; ++bj) { EPI_VALS(bj); float o[8];
#pragma unroll
                for (int e = 0; e < 8; ++e) o[e] = sigmoidf_(v[e]);
                *(u32x4*)(rowp + bj * 128) = pack8(o); } }
    }
};
struct EpiInProjSig8 {
    bf16 *XR, *ACAT, *XP, *GL; const float *SA, *SB;
    template <bool SIG> __device__ __forceinline__ void run(const f32x4 (&acc)[2][2][4][2], const Unit& u, bf16* base, int ld, int ct, const float (&sb)[2][8], int wr, int wc, int fr, int fq, LAS unsigned char* trb) const {
        EPI_FOR_ROWS { const size_t row = EPI_ROW; const float sa = SA[row]; bf16* blk = base + (size_t)EPI_ROW0 * ld + ct * 256 + wc * 32;
#pragma unroll
            for (int bj = 0; bj < 2; ++bj) { EPI_VALS(bj); float o[8];
#pragma unroll
                for (int e = 0; e < 8; ++e) { const float x = (float)__float_as_int(v[e]) * (sa * sb[bj][e]); o[e] = SIG ? sigmoidf_(x) : x; }
                tr_store(trb, bj, fr, fq, blk + bj * 128, ld, pack8(o)); } }
    }
    __device__ __forceinline__ void operator()(const f32x4 (&acc)[2][2][4][2], const Unit& u, int wr, int wc, int fr, int fq, LAS unsigned char* trb) const {
        float sb[2][8];
#pragma unroll
        for (int bj = 0; bj < 2; ++bj)
#pragma unroll
            for (int e = 0; e < 8; ++e) sb[bj][e] = SB[u.pn * 256 + bj * 128 + wc * 32 + 8 * fq + e];
        if (u.pn >= 10) run<true>(acc, u, GL, 2048, u.pn - 10, sb, wr, wc, fr, fq, trb);
        else if (u.pn < 4) run<false>(acc, u, XR, 1024, u.pn, sb, wr, wc, fr, fq, trb);
        else if (u.pn < 8) run<false>(acc, u, ACAT + 512, ACAT_LD, u.pn - 4, sb, wr, wc, fr, fq, trb);
        else run<false>(acc, u, XP, 512, u.pn - 8, sb, wr, wc, fr, fq, trb);
    }
};
struct EpiQ8 {
    bf16* Q; const float *SH, *SQ;
    __device__ __forceinline__ void operator()(const f32x4 (&acc)[2][2][4][2], const Unit& u, int wr, int wc, int fr, int fq, LAS unsigned char* trb) const {
        float sq[2][8];
#pragma unroll
        for (int bj = 0; bj < 2; ++bj)
#pragma unroll
            for (int e = 0; e < 8; ++e) sq[bj][e] = SQ[u.pn * 256 + bj * 128 + wc * 32 + 8 * fq + e];
        EPI_FOR_ROWS { const size_t row = EPI_ROW; const float sa = SH[row]; bf16* blk = Q + (size_t)EPI_ROW0 * 2048 + u.pn * 256 + wc * 32;
#pragma unroll
            for (int bj = 0; bj < 2; ++bj) { EPI_VALS(bj); float o[8];
#pragma unroll
                for (int e = 0; e < 8; ++e) o[e] = (float)__float_as_int(v[e]) * (sa * sq[bj][e]);
                tr_store(trb, bj, fr, fq, blk + bj * 128, 2048, pack8(o)); } }
    }
};
struct EpiGate {
    const bf16* XC; const float *b_rg, *b_ig, *LS8; bf16 *LOGA, *BB;
    __device__ __forceinline__ void operator()(const f32x4 (&acc)[2][2][4][2], const Unit& u, int wr, int wc, int fr, int fq, LAS unsigned char* trb) const {
        const int c0 = (u.pn >> 1) * 256 + (u.pn & 1) * 128 + wc * 32 + 8 * fq;
#pragma unroll
        for (int ai = 0; ai < 2; ++ai) {
            u32x4 xw4[4];
#pragma unroll
            for (int m = 0; m < 4; ++m) xw4[m] = *(const u32x4*)(XC + (size_t)EPI_ROW * 1024 + c0);
#pragma unroll
            for (int m = 0; m < 4; ++m) { const size_t off = (size_t)EPI_ROW * 1024 + c0; const u32x4 xw = xw4[m]; u32x4 ow_l, ow_b;
#pragma unroll
                for (int n = 0; n < 2; ++n) {
                    const f32x4 br = *(const f32x4*)(b_rg + c0 + 4 * n), bi = *(const f32x4*)(b_ig + c0 + 4 * n), ls = *(const f32x4*)(LS8 + c0 + 4 * n);
                    const unsigned x01 = n ? xw.z : xw.x, x23 = n ? xw.w : xw.y;
                    const float xc[4] = {bf_lo(x01), bf_hi(x01), bf_lo(x23), bf_hi(x23)};
                    float la[4], bb[4];
#pragma unroll
                    for (int e = 0; e < 4; ++e) { const float rl = acc[ai][0][m][n][e] + br[e], il = acc[ai][1][m][n][e] + bi[e];
                        const float r = sigmoidf_(rl), ig = sigmoidf_(il); const float l = ls[e] * r; const float t2 = 2.f * l;
                        const float em = (t2 > -0.02f) ? -(t2 * (1.f + t2 * (0.5f + t2 * (1.f / 6.f)))) : (1.f - fast_exp(t2));
                        la[e] = l; bb[e] = sqrtf(em) * ig * xc[e]; }
                    if (n == 0) { ow_l.x = cvt_pk_bf16(la[0], la[1]); ow_l.y = cvt_pk_bf16(la[2], la[3]); ow_b.x = cvt_pk_bf16(bb[0], bb[1]); ow_b.y = cvt_pk_bf16(bb[2], bb[3]); }
                    else { ow_l.z = cvt_pk_bf16(la[0], la[1]); ow_l.w = cvt_pk_bf16(la[2], la[3]); ow_b.z = cvt_pk_bf16(bb[0], bb[1]); ow_b.w = cvt_pk_bf16(bb[2], bb[3]); } }
                const size_t off0 = (size_t)EPI_ROW0 * 1024 + (c0 - 8 * fq);
                tr_store(trb, 0, fr, fq, LOGA + off0, 1024, ow_l); tr_store(trb, 1, fr, fq, BB + off0, 1024, ow_b); }
            asm volatile("" ::: "memory"); }
    }
};
struct EpiMerge {
    const bf16* GL; bf16* MERGED;
    __device__ __forceinline__ void mid(f32x4 (&acc)[2][2][4][2], const Unit& u, int wr, int wc, int fr, int fq) const {
        EPI_FOR_ROWS { const size_t row = EPI_ROW;
#pragma unroll
            for (int bj = 0; bj < 2; ++bj) { const int c0 = u.pn * 256 + bj * 128 + wc * 32 + 8 * fq;
                float ga[8], gb[8]; unpack8(*(const u32x4*)(GL + row * 2048 + c0), ga); unpack8(*(const u32x4*)(GL + row * 2048 + 1024 + c0), gb);
#pragma unroll
                for (int e = 0; e < 8; ++e) acc[ai][bj][m][e >> 2][e & 3] *= gb[e] * __builtin_amdgcn_rcpf(fmaxf(ga[e], 1e-12f)); }
            if (m & 1) asm volatile("" ::: "memory"); }
    }
    __device__ __forceinline__ void operator()(const f32x4 (&acc)[2][2][4][2], const Unit& u, int wr, int wc, int fr, int fq, LAS unsigned char* trb) const {
        EPI_FOR_ROWS { const size_t row = EPI_ROW;
#pragma unroll
            for (int bj = 0; bj < 2; ++bj) { const int c0 = u.pn * 256 + bj * 128 + wc * 32 + 8 * fq; EPI_VALS(bj);
                float ga[8], o[8]; unpack8(*(const u32x4*)(GL + row * 2048 + c0), ga);
#pragma unroll
                for (int e = 0; e < 8; ++e) o[e] = fmaxf(ga[e], 1e-12f) * v[e];
                tr_store(trb, bj, fr, fq, MERGED + (size_t)EPI_ROW0 * 1024 + (c0 - 8 * fq), 1024, pack8(o)); } }
    }
};
struct EpiOut {
    const bf16* H0; bf16* V1;
    __device__ __forceinline__ void operator()(const f32x4 (&acc)[2][2][4][2], const Unit& u, int wr, int wc, int fr, int fq, LAS unsigned char* trb) const {
        EPI_FOR_ROWS { const size_t row = EPI_ROW;
#pragma unroll
            for (int bj = 0; bj < 2; ++bj) { const int c0 = u.pn * 256 + bj * 128 + wc * 32 + 8 * fq; EPI_VALS(bj);
                float h[8], o[8]; unpack8(*(const u32x4*)(H0 + row * 1024 + c0), h);
#pragma unroll
                for (int e = 0; e < 8; ++e) o[e] = ALPHA * h[e] + v[e];
                tr_store(trb, bj, fr, fq, V1 + (size_t)EPI_ROW0 * 1024 + (c0 - 8 * fq), 1024, pack8(o)); } }
    }
};
struct EpiBf16 {
    bf16* O; int ld;
    __device__ __forceinline__ void operator()(const f32x4 (&acc)[2][2][4][2], const Unit& u, int wr, int wc, int fr, int fq) const {
        EPI_FOR_ROWS { bf16* rowp = O + (size_t)EPI_ROW * ld + u.pn * 256 + wc * 32 + 8 * fq;
#pragma unroll
            for (int bj = 0; bj < 2; ++bj) { EPI_VALS(bj); *(u32x4*)(rowp + bj * 128) = pack8(v); } }
    }
};
}

#define XB_TMO      128
#define XB_XCNT(j)  (256  + 64 * (j))
#define XB_XSUB(j)  (1280 + 64 * (j))
#define XB_XGEN(j)  (2304 + 64 * (j))
#define XB_TOP      3328
#define XB_TOPGEN   3392
#define XCD_BAR_WORDS 3456
#define XB_SPIN_CAP (1u << 18)
__device__ __forceinline__ unsigned xb_ld(unsigned* p)              { return __hip_atomic_load(p, __ATOMIC_RELAXED, __HIP_MEMORY_SCOPE_AGENT); }
__device__ __forceinline__ unsigned xb_add(unsigned* p, unsigned v) { return __hip_atomic_fetch_add(p, v, __ATOMIC_RELAXED, __HIP_MEMORY_SCOPE_AGENT); }
__device__ __forceinline__ unsigned xb_xcc_id() { return (unsigned)__builtin_amdgcn_s_getreg((3 << 11) | 20) & 0xFu; }
#define XB_SPIN(cond, bar) do { unsigned _sp = 0; while (cond) { __builtin_amdgcn_s_sleep(1); \
    if ((++_sp & 255u) == 0u) { if (xb_ld(&(bar)[XB_TMO])) break; if (_sp > XB_SPIN_CAP) { atomicAdd(&(bar)[XB_TMO], 1u); break; } } } } while (0)
struct XcdBarrier { unsigned* bar; unsigned x; volatile LAS unsigned* st; };
__device__ __forceinline__ XcdBarrier xcd_barrier_post(unsigned* bar, volatile LAS unsigned* st) {
    XcdBarrier b; b.bar = bar; b.x = xb_xcc_id(); b.st = st;
    if (threadIdx.x == 0) (void)xb_add(&bar[XB_XCNT(b.x)], 1u);
    return b;
}
__device__ __forceinline__ void xcd_barrier_complete(unsigned* bar, unsigned x, unsigned& nloc, unsigned& nx) {
    const unsigned G = gridDim.x * gridDim.y * gridDim.z;
    unsigned sum, cnt, mine, sp = 0u;
    for (;;) {
        sum = 0u; cnt = 0u; mine = 0u;
#pragma unroll
        for (unsigned j = 0; j < 16; ++j) { const unsigned c = xb_ld(&bar[XB_XCNT(j)]); sum += c; cnt += (c > 0u) ? 1u : 0u; mine = (j == x) ? c : mine; }
        if (sum == G) break;
        __builtin_amdgcn_s_sleep(1);
        if ((++sp & 255u) == 0u) { if (xb_ld(&bar[XB_TMO])) break; if (sp > XB_SPIN_CAP) { atomicAdd(&bar[XB_TMO], 1u); break; } }
    }
    nloc = mine > 0u ? mine : 1u; nx = cnt > 0u ? cnt : 1u;
}
__device__ __forceinline__ void xcd_barrier(const XcdBarrier& b) {
    asm volatile("s_waitcnt vmcnt(0)" ::: "memory");
    __syncthreads();
    if (threadIdx.x == 0) {
        unsigned* bar = b.bar;
        __builtin_amdgcn_s_waitcnt(0);
        unsigned nloc = b.st[0], nx = b.st[1];
        if (nloc == 0u) { xcd_barrier_complete(bar, b.x, nloc, nx); b.st[0] = nloc; b.st[1] = nx; }
        const unsigned old = xb_add(&bar[XB_XSUB(b.x)], 1u);
        const unsigned gen = old / nloc;
        if (old + 1u == (gen + 1u) * nloc) {
            __builtin_amdgcn_fence(__ATOMIC_RELEASE, "agent");
            asm volatile("s_waitcnt vmcnt(0)" ::: "memory");
            const unsigned og = xb_add(&bar[XB_TOP], 1u);
            const unsigned tg = og / nx;
            if (og + 1u == (tg + 1u) * nx) xb_add(&bar[XB_TOPGEN], 1u);
            else XB_SPIN(xb_ld(&bar[XB_TOPGEN]) == tg, bar);
            __builtin_amdgcn_fence(__ATOMIC_ACQUIRE, "agent");
            xb_add(&bar[XB_XGEN(b.x)], 1u);
            asm volatile("s_waitcnt vmcnt(0)" ::: "memory");
        } else {
            XB_SPIN(xb_ld(&bar[XB_XGEN(b.x)]) == gen, bar);
            __builtin_amdgcn_fence(__ATOMIC_ACQUIRE, "agent");
            asm volatile("s_waitcnt vmcnt(0)" ::: "memory");
        }
    }
    __syncthreads();
}

struct Args { const float* in[25]; float* out; unsigned char* ws; int ph_lo, ph_hi; };
enum { I_X = 0, I_META, I_LNIG, I_LNIB, I_WIN, I_CONVW, I_CONVB, I_WRG, I_BRG, I_WIG, I_BIG, I_LRUL, I_WPA, I_POOLW, I_POOLS, I_WPB, I_WOUT, I_LN1G, I_LN1B, I_WQ, I_KEYS, I_EU, I_EV, I_LN2G, I_LN2B };
constexpr int NPHASES = 14;

struct Frame { LAS unsigned char* lds; int tid, lane, wave, G, gw, NGW; };

__device__ __forceinline__ void transpose_item(const float* src, int lds_, bf16* dst, int ldt, LAS float* scr, int lane) {
#pragma unroll 8
    for (int i = 0; i < 32; ++i) { const int kk = 2 * i + (lane >> 5); scr[kk * 33 + (lane & 31)] = src[(size_t)kk * lds_ + (lane & 31)]; }
    LDS_WAIT();
    const int c = lane & 7;
#pragma unroll
    for (int j = 0; j < 4; ++j) { const int n = (lane >> 3) + 8 * j; const LAS float* s = scr + (8 * c) * 33 + n;
        u32x4 o; o.x = cvt_pk_bf16(s[0 * 33], s[1 * 33]); o.y = cvt_pk_bf16(s[2 * 33], s[3 * 33]); o.z = cvt_pk_bf16(s[4 * 33], s[5 * 33]); o.w = cvt_pk_bf16(s[6 * 33], s[7 * 33]);
        *(u32x4*)(dst + (size_t)n * ldt + 8 * c) = o; }
    LDS_WAIT();
}
__device__ __forceinline__ unsigned pack_i8x4(const f32x4 v, float inv) {
    unsigned p = 0u;
    p = __builtin_amdgcn_cvt_pk_u8_f32(__builtin_rintf(v.x * inv) + 128.f, 0u, p); p = __builtin_amdgcn_cvt_pk_u8_f32(__builtin_rintf(v.y * inv) + 128.f, 1u, p);
    p = __builtin_amdgcn_cvt_pk_u8_f32(__builtin_rintf(v.z * inv) + 128.f, 2u, p); p = __builtin_amdgcn_cvt_pk_u8_f32(__builtin_rintf(v.w * inv) + 128.f, 3u, p);
    return p ^ 0x80808080u; }
__device__ __forceinline__ float absmax4(const f32x4 (&v)[4]) { float m = 0.f;
#pragma unroll
    for (int j = 0; j < 4; ++j) m = fmaxf(fmaxf(m, fmaxf(fabsf(v[j].x), fabsf(v[j].y))), fmaxf(fabsf(v[j].z), fabsf(v[j].w)));
    return wave_max(m); }
__device__ __forceinline__ void ln_row(const float* xrow, const float* g, const float* b, int lane, f32x4 (&v)[4]) {
    float s = 0.f;
#pragma unroll
    for (int j = 0; j < 4; ++j) { v[j] = *((const f32x4*)xrow + lane + 64 * j); s += (v[j].x + v[j].y) + (v[j].z + v[j].w); }
    const float mean = wave_sum(s) * (1.f / D); float s2 = 0.f;
#pragma unroll
    for (int j = 0; j < 4; ++j) { v[j] = v[j] - mean; s2 += (v[j].x * v[j].x + v[j].y * v[j].y) + (v[j].z * v[j].z + v[j].w * v[j].w); }
    const float rstd = 1.f / sqrtf(wave_sum(s2) * (1.f / D) + LN_EPS);
#pragma unroll
    for (int j = 0; j < 4; ++j) { const f32x4 gg = *((const f32x4*)g + lane + 64 * j), bb = *((const f32x4*)b + lane + 64 * j); v[j] = v[j] * rstd * gg + bb; }
}
__device__ __forceinline__ void ln_vals(f32x4 (&v)[4], const float* g, const float* b, int lane) {
    float s = 0.f;
#pragma unroll
    for (int j = 0; j < 4; ++j) s += (v[j].x + v[j].y) + (v[j].z + v[j].w);
    const float mean = wave_sum(s) * (1.f / D); float s2 = 0.f;
#pragma unroll
    for (int j = 0; j < 4; ++j) { v[j] = v[j] - mean; s2 += (v[j].x * v[j].x + v[j].y * v[j].y) + (v[j].z * v[j].z + v[j].w * v[j].w); }
    const float rstd = 1.f / sqrtf(wave_sum(s2) * (1.f / D) + LN_EPS);
#pragma unroll
    for (int j = 0; j < 4; ++j) { const f32x4 gg = *((const f32x4*)g + lane + 64 * j), bb = *((const f32x4*)b + lane + 64 * j); v[j] = v[j] * rstd * gg + bb; }
}
__device__ __forceinline__ void ln_row_bf(const bf16* xrow, const float* g, const float* b, int lane, f32x4 (&v)[4]) {
    float s = 0.f;
#pragma unroll
    for (int j = 0; j < 4; ++j) { const u32x2 w = *((const u32x2*)xrow + lane + 64 * j); v[j] = (f32x4){bf_lo(w.x), bf_hi(w.x), bf_lo(w.y), bf_hi(w.y)}; s += (v[j].x + v[j].y) + (v[j].z + v[j].w); }
    const float mean = wave_sum(s) * (1.f / D); float s2 = 0.f;
#pragma unroll
    for (int j = 0; j < 4; ++j) { v[j] = v[j] - mean; s2 += (v[j].x * v[j].x + v[j].y * v[j].y) + (v[j].z * v[j].z + v[j].w * v[j].w); }
    const float rstd = 1.f / sqrtf(wave_sum(s2) * (1.f / D) + LN_EPS);
#pragma unroll
    for (int j = 0; j < 4; ++j) { const f32x4 gg = *((const f32x4*)g + lane + 64 * j), bb = *((const f32x4*)b + lane + 64 * j); v[j] = v[j] * rstd * gg + bb; }
}
__device__ __forceinline__ void store_row_bf16(bf16* orow, int lane, const f32x4 (&v)[4]) {
#pragma unroll
    for (int j = 0; j < 4; ++j) { u32x2 w; w.x = cvt_pk_bf16(v[j].x, v[j].y); w.y = cvt_pk_bf16(v[j].z, v[j].w); *((u32x2*)orow + lane + 64 * j) = w; }
}

__device__ __forceinline__ void p0_prologue(const Frame& F, const Args& a) {
    unsigned char* ws = a.ws;
    if (blockIdx.x < 24) {
        LAS float* hm = (LAS float*)F.lds;
        LAS float* part = (LAS float*)(F.lds + 65536);
        for (int r = F.wave * 2; r < F.wave * 2 + 2; ++r) { f32x4 v[4]; ln_row(a.in[I_META] + (size_t)r * D, a.in[I_LNIG], a.in[I_LNIB], F.lane, v);
#pragma unroll
            for (int j = 0; j < 4; ++j) *((LAS f32x4*)(hm + r * 1024) + F.lane + 64 * j) = v[j]; }
        __syncthreads();
        const int cgp = blockIdx.x; const int col = (cgp < 16 ? cgp * 64 : 2048 + (cgp - 16) * 64) + F.lane;
        float acc[16];
#pragma unroll
        for (int t = 0; t < 16; ++t) acc[t] = 0.f;
        const float* w = a.in[I_WIN];
        for (int k = F.wave * 128; k < F.wave * 128 + 128; k += 4) {
            const float w0 = w[(size_t)(k + 0) * NPROJ + col], w1 = w[(size_t)(k + 1) * NPROJ + col], w2 = w[(size_t)(k + 2) * NPROJ + col], w3 = w[(size_t)(k + 3) * NPROJ + col];
#pragma unroll
            for (int t = 0; t < 16; ++t) { const f32x4 h = *(const LAS f32x4*)(hm + t * 1024 + k); acc[t] += h.x * w0 + h.y * w1 + h.z * w2 + h.w * w3; }
        }
#pragma unroll
        for (int t = 0; t < 16; ++t) part[(F.wave * 16 + t) * 64 + F.lane] = acc[t];
        __syncthreads();
        float* PROJM = (float*)(ws + WS_PROJM);
        for (int idx = F.tid; idx < 16 * 64; idx += NTHREADS) { const int t = idx >> 6, l = idx & 63; float s = 0.f;
#pragma unroll
            for (int w8 = 0; w8 < 8; ++w8) s += part[(w8 * 16 + t) * 64 + l];
            PROJM[t * 1536 + cgp * 64 + l] = s; }
        __syncthreads();
    }
    if (blockIdx.x == F.G - 1) { float* LS8 = (float*)(ws + WS_LS8);
        for (int c = F.tid; c < D; c += NTHREADS) { const float L = a.in[I_LRUL][c]; LS8[c] = 8.f * (fminf(L, 0.f) - log1pf(expf(-fabsf(L)))); } }
    { const float *pw = a.in[I_POOLW], *ps = a.in[I_POOLS], *wpb = a.in[I_WPB]; bf16* BC = (bf16*)(ws + WS_BCAT);
      for (int it = F.gw; it < 128 * 16; it += F.NGW) { const int k0 = (it >> 4) * 4, eb = it & 15, gI = k0 >> 7;
          float pa[4], pb[4], acc[4];
#pragma unroll
          for (int i = 0; i < 4; ++i) { pa[i] = pw[(size_t)(k0 + i) * 128 + F.lane] * ps[gI * 128 + F.lane]; pb[i] = pw[(size_t)(k0 + i) * 128 + 64 + F.lane] * ps[gI * 128 + 64 + F.lane]; acc[i] = 0.f; }
          const float* wcol = wpb + (size_t)(gI * 128) * D + eb * 64 + F.lane;
#pragma unroll 8
          for (int d = 0; d < 64; ++d) { const float w = wcol[(size_t)d * D];
#pragma unroll
              for (int i = 0; i < 4; ++i) acc[i] += __builtin_bit_cast(float, __builtin_amdgcn_readlane(__builtin_bit_cast(int, pa[i]), d)) * w; }
#pragma unroll 8
          for (int d = 0; d < 64; ++d) { const float w = wcol[(size_t)(64 + d) * D];
#pragma unroll
              for (int i = 0; i < 4; ++i) acc[i] += __builtin_bit_cast(float, __builtin_amdgcn_readlane(__builtin_bit_cast(int, pb[i]), d)) * w; }
          u32x2 o; o.x = cvt_pk_bf16(acc[0], acc[1]); o.y = cvt_pk_bf16(acc[2], acc[3]);
          *(u32x2*)(BC + (size_t)(eb * 64 + F.lane) * 1536 + k0) = o; } }
    { LAS float* scr = (LAS float*)(F.lds + F.wave * 16384);
      constexpr int I_IN = 16 * 144, I_PA = 16 * 32, I_OUT = 16 * 32, I_Q = 16 * 64, I_G = 8 * 32;
      constexpr int NIT = I_IN + I_PA + I_OUT + I_Q + I_G;
      for (int it = F.gw; it < NIT; it += F.NGW) { int r = it;
          if (r < I_IN) { const int kb = r / 144, nb = r % 144; transpose_item(a.in[I_WIN] + (size_t)(64 * kb) * NPROJ + 32 * nb, NPROJ, (bf16*)(ws + WS_WINT) + (size_t)(32 * nb) * 1024 + 64 * kb, 1024, scr, F.lane); continue; } r -= I_IN;
          if (r < I_PA) { const int kb = r / 32, nb = r % 32; transpose_item(a.in[I_WPA] + (size_t)(64 * kb) * D + 32 * nb, D, (bf16*)(ws + WS_BCAT) + (size_t)(32 * nb) * 1536 + 512 + 64 * kb, 1536, scr, F.lane); continue; } r -= I_PA;
          if (r < I_OUT) { const int kb = r / 32, nb = r % 32; transpose_item(a.in[I_WOUT] + (size_t)(64 * kb) * D + 32 * nb, D, (bf16*)(ws + WS_WOUTT) + (size_t)(32 * nb) * 1024 + 64 * kb, 1024, scr, F.lane); continue; } r -= I_OUT;
          if (r < I_Q) { const int kb = r / 64, nb = r % 64; transpose_item(a.in[I_WQ] + (size_t)(64 * kb) * 2048 + 32 * nb, 2048, (bf16*)(ws + WS_WQT) + (size_t)(32 * nb) * 1024 + 64 * kb, 1024, scr, F.lane); continue; } r -= I_Q;
          { const int mat = r / 32, rr = r % 32, kb = rr / 8, nb = rr % 8, gate = mat >> 2, n = mat & 3;
            const float* src = a.in[gate ? I_WIG : I_WRG] + (size_t)n * 65536 + (size_t)(64 * kb) * 256 + 32 * nb;
            const int n0 = 32 * nb, drow = (n * 2 + (n0 >> 7)) * 256 + gate * 128 + (n0 & 127);
            transpose_item(src, 256, (bf16*)(ws + WS_GATET) + (size_t)drow * 256 + 64 * kb, 256, scr, F.lane); } } }
    { const float* sk = a.in[I_KEYS]; bf16* kd = (bf16*)(ws + WS_KEYS);
      for (int i = F.gw * 64 + F.lane; i < 8 * 2 * 128 * 128 / 8; i += F.NGW * 64) { const f32x4 x0 = *((const f32x4*)sk + 2 * i), x1 = *((const f32x4*)sk + 2 * i + 1);
          u32x4 o; o.x = cvt_pk_bf16(x0.x, x0.y); o.y = cvt_pk_bf16(x0.z, x0.w); o.z = cvt_pk_bf16(x1.x, x1.y); o.w = cvt_pk_bf16(x1.z, x1.w); *((u32x4*)kd + i) = o; } }
    { bf16* H0 = (bf16*)(ws + WS_H0);
      f32x4 nx[4];
#pragma unroll
      for (int j = 0; j < 4; ++j) nx[j] = *((const f32x4*)(a.in[I_X] + (size_t)(F.gw < M ? F.gw : 0) * D) + F.lane + 64 * j);
#pragma unroll 1
      for (int m = F.gw; m < M; m += F.NGW) { f32x4 v[4]; const int mn = m + F.NGW < M ? m + F.NGW : m;
#pragma unroll
          for (int j = 0; j < 4; ++j) { v[j] = nx[j]; nx[j] = *((const f32x4*)(a.in[I_X] + (size_t)mn * D) + F.lane + 64 * j); }
          ln_vals(v, a.in[I_LNIG], a.in[I_LNIB], F.lane); store_row_bf16(H0 + (size_t)m * D, F.lane, v);
          const float am = fmaxf(absmax4(v), 1e-20f), inv = 127.f / am;
#pragma unroll
          for (int j = 0; j < 4; ++j) *((unsigned*)(ws + WS_H0Q + (size_t)m * D) + F.lane + 64 * j) = pack_i8x4(v[j], inv);
          if (F.lane == 0) ((float*)(ws + WS_SA))[m] = am * (1.f / 127.f); } }
}

__device__ __forceinline__ void p2_convpool(const Frame& F, const Args& a) {
    unsigned char* ws = a.ws; const float* PROJM = (const float*)(ws + WS_PROJM);
    if (blockIdx.x < 4) {
        const int n = blockIdx.x; LAS float* xcm = (LAS float*)F.lds;
        for (int idx = F.tid; idx < 4096; idx += NTHREADS) { const int t = idx >> 8, c = n * 256 + (idx & 255); float v = a.in[I_CONVB][c];
#pragma unroll
            for (int jj = 0; jj < 4; ++jj) { const int tt = t + jj - 3; if (tt >= 0) v += a.in[I_CONVW][jj * D + c] * PROJM[tt * 1536 + c]; }
            xcm[idx] = v; }
        __syncthreads();
        if (F.wave < 4) { const int cl = F.wave * 64 + F.lane, c = n * 256 + cl; float rl[16], il[16];
#pragma unroll
            for (int t = 0; t < 16; ++t) { rl[t] = 0.f; il[t] = 0.f; }
#pragma unroll 8
            for (int k = 0; k < 256; ++k) { const float wr_ = a.in[I_WRG][(size_t)(n * 256 + k) * 256 + cl], wi_ = a.in[I_WIG][(size_t)(n * 256 + k) * 256 + cl];
#pragma unroll
                for (int t = 0; t < 16; ++t) { const float x = xcm[t * 256 + k]; rl[t] += x * wr_; il[t] += x * wi_; } }
            const float brg = a.in[I_BRG][c], big = a.in[I_BIG][c], ls8 = ((const float*)(ws + WS_LS8))[c]; float h = 0.f;
#pragma unroll
            for (int t = 0; t < 16; ++t) { const float r = sigmoidf_(rl[t] + brg), ig = sigmoidf_(il[t] + big); const float l = ls8 * r; const float aa = fast_exp(l);
                const float em = -expm1f(2.f * l); h = aa * h + sqrtf(em) * ig * xcm[t * 256 + cl]; }
            ((float*)(ws + WS_HMETA))[c] = h; }
        __syncthreads();
    }
    { const bf16* XR = (const bf16*)(ws + WS_XR); bf16* XC = (bf16*)(ws + WS_XC); const float *cw = a.in[I_CONVW], *cb = a.in[I_CONVB];
      const int gt = blockIdx.x * NTHREADS + F.tid, GT = F.G * NTHREADS;
      for (int idx = gt; idx < (M / 8) * 128; idx += GT) { const int row0 = (idx >> 7) * 8, c0 = (idx & 127) * 8, t0 = row0 & (SEQ - 1);
          u32x4 xw[11];
          if (t0 >= 8) {
#pragma unroll
              for (int i = 0; i < 11; ++i) xw[i] = *(const u32x4*)(XR + (size_t)(row0 - 3 + i) * D + c0);
          } else {
#pragma unroll
              for (int i = 0; i < 11; ++i) { const int tt = t0 - 3 + i;
                  if (tt >= 0) xw[i] = *(const u32x4*)(XR + (size_t)(row0 - 3 + i) * D + c0);
                  else { float x[8];
#pragma unroll
                      for (int e = 0; e < 8; ++e) x[e] = PROJM[(NMETA + tt) * 1536 + c0 + e];
                      xw[i] = pack8(x); } } }
          float w4[4][8], b8[8];
#pragma unroll
          for (int e = 0; e < 8; ++e) { b8[e] = cb[c0 + e];
#pragma unroll
              for (int jj = 0; jj < 4; ++jj) w4[jj][e] = cw[jj * D + c0 + e]; }
#pragma unroll
          for (int r = 0; r < 8; ++r) { float x0[8], x1[8], x2[8], x3[8], o[8]; unpack8(xw[r], x0); unpack8(xw[r + 1], x1); unpack8(xw[r + 2], x2); unpack8(xw[r + 3], x3);
#pragma unroll
              for (int e = 0; e < 8; ++e) o[e] = b8[e] + w4[0][e] * x0[e] + w4[1][e] * x1[e] + w4[2][e] * x2[e] + w4[3][e] * x3[e];
              *(u32x4*)(XC + (size_t)(row0 + r) * D + c0) = pack8(o); } }
      const bf16* XP = (const bf16*)(ws + WS_XP); bf16* PO = (bf16*)(ws + WS_ACAT);
      for (int idx = gt; idx < (M / 4) * 64; idx += GT) { const int row0 = (idx >> 6) * 4, c0 = (idx & 63) * 8, t0 = row0 & (SEQ - 1), w = 2 << (c0 >> 7);
          float X[19][8];
          if (t0 >= 16) { u32x4 xw[19];
#pragma unroll
              for (int i = 0; i < 19; ++i) xw[i] = (i >= 16 - w) ? *(const u32x4*)(XP + (size_t)(row0 - 15 + i) * DPOOL + c0) : (u32x4){0u, 0u, 0u, 0u};
#pragma unroll
              for (int i = 0; i < 19; ++i) unpack8(xw[i], X[i]);
          } else {
#pragma unroll
              for (int i = 0; i < 19; ++i) { const int tt = t0 - 15 + i;
                  if (tt >= 0) unpack8(*(const u32x4*)(XP + (size_t)(row0 - 15 + i) * DPOOL + c0), X[i]);
                  else {
#pragma unroll
                      for (int e = 0; e < 8; ++e) X[i][e] = PROJM[(NMETA + tt) * 1536 + 1024 + c0 + e]; } } }
          const float inv = 1.f / (float)w;
#pragma unroll
          for (int r = 0; r < 4; ++r) { float s[8];
#pragma unroll
              for (int e = 0; e < 8; ++e) s[e] = 0.f;
#pragma unroll
              for (int j = 0; j < 16; ++j) { const bool on = j < w;
#pragma unroll
                  for (int e = 0; e < 8; ++e) s[e] += on ? X[15 + r - j][e] : 0.f; }
              float o[8];
#pragma unroll
              for (int e = 0; e < 8; ++e) o[e] = s[e] * inv - X[15 + r][e];
              *(u32x4*)(PO + (size_t)(row0 + r) * ACAT_LD + c0) = pack8(o); } } }
}

__device__ __forceinline__ void p4_scan_agg(const Frame& F, const Args& a) {
    unsigned char* ws = a.ws; const bf16* LOGA = (const bf16*)(ws + WS_LOGA); const bf16* BB = (const bf16*)(ws + WS_BB);
    float* AGG = (float*)(ws + WS_AGG); float* SUB = (float*)(ws + WS_SUBAGG);
    LAS float* sh = (LAS float*)F.lds;
    const int s = F.tid >> 7, o = F.tid & 127;
    for (int item = blockIdx.x; item < 256; item += F.G) {
        const size_t row0 = (size_t)item * 256 + s * 64;
        float sl[8], S[8];
#pragma unroll
        for (int e = 0; e < 8; ++e) { sl[e] = 0.f; S[e] = 0.f; }
#pragma unroll 4
        for (int r = 0; r < 64; ++r) { float la[8], bb[8]; unpack8(*(const u32x4*)(LOGA + (row0 + r) * D + o * 8), la); unpack8(*(const u32x4*)(BB + (row0 + r) * D + o * 8), bb);
#pragma unroll
            for (int e = 0; e < 8; ++e) { sl[e] += la[e]; S[e] = fast_exp(la[e]) * S[e] + bb[e]; } }
#pragma unroll
        for (int e = 0; e < 8; ++e) { sh[((s * 1024) + o * 8 + e) * 2] = sl[e]; sh[((s * 1024) + o * 8 + e) * 2 + 1] = S[e];
            SUB[(((size_t)item * 4 + s) * 1024 + o * 8 + e) * 2] = sl[e]; SUB[(((size_t)item * 4 + s) * 1024 + o * 8 + e) * 2 + 1] = S[e]; }
        __syncthreads();
        for (int c = F.tid; c < 1024; c += NTHREADS) { float tl = 0.f, tS = 0.f;
#pragma unroll
            for (int k = 0; k < 4; ++k) { const float l = sh[(k * 1024 + c) * 2], Sk = sh[(k * 1024 + c) * 2 + 1]; tS = fast_exp(l) * tS + Sk; tl += l; }
            AGG[((size_t)item * 1024 + c) * 2] = tl; AGG[((size_t)item * 1024 + c) * 2 + 1] = tS; }
        __syncthreads();
    }
}
__device__ __forceinline__ void p5_scan_apply(const Frame& F, const Args& a) {
    unsigned char* ws = a.ws; const bf16* LOGA = (const bf16*)(ws + WS_LOGA); const bf16* BB = (const bf16*)(ws + WS_BB); bf16* RG = (bf16*)(ws + WS_ACAT) + 512;
    const float* AGG = (const float*)(ws + WS_AGG); const float* SUB = (const float*)(ws + WS_SUBAGG); const float* HMETA = (const float*)(ws + WS_HMETA);
    LAS float* carry = (LAS float*)F.lds;
    const int s = F.tid >> 7, o = F.tid & 127;
    for (int item = blockIdx.x; item < 256; item += F.G) {
        const int b = item >> 5, ch = item & 31;
        for (int c = F.tid; c < 1024; c += NTHREADS) { float h = HMETA[c];
            for (int cc = 0; cc < ch; ++cc) { const float l = AGG[((size_t)(b * 32 + cc) * 1024 + c) * 2], Sk = AGG[((size_t)(b * 32 + cc) * 1024 + c) * 2 + 1]; h = fast_exp(l) * h + Sk; }
            carry[c] = h; }
        __syncthreads();
        float h[8];
#pragma unroll
        for (int e = 0; e < 8; ++e) h[e] = carry[o * 8 + e];
        for (int ss = 0; ss < s; ++ss) {
#pragma unroll
            for (int e = 0; e < 8; ++e) { const float l = SUB[(((size_t)item * 4 + ss) * 1024 + o * 8 + e) * 2], Sk = SUB[(((size_t)item * 4 + ss) * 1024 + o * 8 + e) * 2 + 1]; h[e] = fast_exp(l) * h[e] + Sk; } }
        const size_t row0 = (size_t)item * 256 + s * 64;
#pragma unroll 4
        for (int r = 0; r < 64; ++r) { float la[8], bb[8], gt[8]; const size_t off = (row0 + r) * D + o * 8;
            const size_t offg = (row0 + r) * ACAT_LD + o * 8;
            unpack8(*(const u32x4*)(LOGA + off), la); unpack8(*(const u32x4*)(BB + off), bb); unpack8(*(const u32x4*)(RG + offg), gt); float ov[8];
#pragma unroll
            for (int e = 0; e < 8; ++e) { h[e] = fast_exp(la[e]) * h[e] + bb[e]; ov[e] = h[e] * gelu_tanh(gt[e]); }
            *(u32x4*)(RG + offg) = pack8(ov); }
        __syncthreads();
    }
}

__device__ __forceinline__ void p8_ln1(const Frame& F, const Args& a) {
    unsigned char* ws = a.ws; const bf16* V1 = (const bf16*)(ws + WS_V1); bf16* H1 = (bf16*)(ws + WS_H1);
    unsigned char* H8 = ws + WS_H8; float* SH = (float*)(ws + WS_SH);
    u32x2 nx[4];
#pragma unroll
    for (int j = 0; j < 4; ++j) nx[j] = *((const u32x2*)(V1 + (size_t)(F.gw < M ? F.gw : 0) * D) + F.lane + 64 * j);
#pragma unroll 1
    for (int m = F.gw; m < M; m += F.NGW) { f32x4 v[4]; const int mn = m + F.NGW < M ? m + F.NGW : m;
#pragma unroll
        for (int j = 0; j < 4; ++j) { v[j] = (f32x4){bf_lo(nx[j].x), bf_hi(nx[j].x), bf_lo(nx[j].y), bf_hi(nx[j].y)}; nx[j] = *((const u32x2*)(V1 + (size_t)mn * D) + F.lane + 64 * j); }
        ln_vals(v, a.in[I_LN1G], a.in[I_LN1B], F.lane); store_row_bf16(H1 + (size_t)m * D, F.lane, v);
        const float am = fmaxf(absmax4(v), 1e-20f), inv = 127.f / am;
        u32x4 q; q.x = pack_i8x4(v[0], inv); q.y = pack_i8x4(v[1], inv); q.z = pack_i8x4(v[2], inv); q.w = pack_i8x4(v[3], inv);
        *((u32x4*)(H8 + (size_t)m * D) + F.lane) = q; if (F.lane == 0) SH[m] = am * (1.f / 127.f); }
    { const bf16* WT = (const bf16*)(ws + WS_WQT); unsigned char* WQ8 = ws + WS_WQ8; float* SQ = (float*)(ws + WS_SQ);
      for (int r = F.gw; r < 2048; r += F.NGW) { f32x4 v[4];
#pragma unroll
          for (int j = 0; j < 4; ++j) { const u32x2 w = *((const u32x2*)(WT + (size_t)r * 1024) + F.lane + 64 * j); v[j] = (f32x4){bf_lo(w.x), bf_hi(w.x), bf_lo(w.y), bf_hi(w.y)}; }
          const float am = fmaxf(absmax4(v), 1e-20f), inv = 127.f / am;
          u32x4 q; q.x = pack_i8x4(v[0], inv); q.y = pack_i8x4(v[1], inv); q.z = pack_i8x4(v[2], inv); q.w = pack_i8x4(v[3], inv);
          *((u32x4*)(WQ8 + (size_t)r * 1024) + F.lane) = q; if (F.lane == 0) SQ[r] = am * (1.f / 127.f); } }
}
__device__ __forceinline__ void convert_tables(const Frame& F, const Args& a) {
    unsigned char* ws = a.ws;
    unsigned char* U8 = ws + WS_U8; unsigned char* V8 = ws + WS_V8; unsigned* SUV = (unsigned*)(ws + WS_SU);
    f32x4 un[4], vn[4];
    { const int e0 = F.gw < 16384 ? F.gw : 0;
#pragma unroll
      for (int j = 0; j < 4; ++j) { un[j] = *((const f32x4*)(a.in[I_EU] + (size_t)e0 * D) + F.lane + 64 * j); vn[j] = *((const f32x4*)(a.in[I_EV] + (size_t)e0 * D) + F.lane + 64 * j); } }
#pragma unroll 1
    for (int e = F.gw; e < 16384; e += F.NGW) { f32x4 u[4], v[4];
#pragma unroll
        for (int j = 0; j < 4; ++j) { u[j] = un[j]; v[j] = vn[j]; }
        { const int en = e + F.NGW < 16384 ? e + F.NGW : e;
#pragma unroll
          for (int j = 0; j < 4; ++j) { un[j] = *((const f32x4*)(a.in[I_EU] + (size_t)en * D) + F.lane + 64 * j); vn[j] = *((const f32x4*)(a.in[I_EV] + (size_t)en * D) + F.lane + 64 * j); } }
        const float amu = fmaxf(absmax4(u), 1e-20f), amv = fmaxf(absmax4(v), 1e-20f);
        const unsigned sc = cvt_pk_bf16(amu * (1.f / 127.f) * 1.004f, amv * (1.f / 127.f) * 1.004f);
        const float invu = 1.f / bf_lo(sc), invv = 1.f / bf_hi(sc);
        u32x4 q; q.x = pack_i8x4(u[0], invu); q.y = pack_i8x4(u[1], invu); q.z = pack_i8x4(u[2], invu); q.w = pack_i8x4(u[3], invu);
        *((u32x4*)(U8 + (size_t)e * D) + F.lane) = q;
#pragma unroll
        for (int j = 0; j < 4; ++j) *((unsigned*)(V8 + (size_t)e * D) + F.lane + 64 * j) = pack_i8x4(v[j], invv);
        if (F.lane == 0) SUV[e] = sc; }
}

constexpr int KPITCH = 272;
typedef float f32x16 __attribute__((ext_vector_type(16)));
__device__ __forceinline__ void ce_desc(float& a, float& b) { float hi, lo; asm("v_max_f32 %0, %1, %2" : "=v"(hi) : "v"(a), "v"(b)); asm("v_min_f32 %0, %1, %2" : "=v"(lo) : "v"(a), "v"(b)); a = hi; b = lo; }
__device__ __forceinline__ float max_asm(float a, float b) { float hi; asm("v_max_f32 %0, %1, %2" : "=v"(hi) : "v"(a), "v"(b)); return hi; }
template <int B> __device__ __forceinline__ void sort16_desc(float (&v)[64]) {
#define S16(a, b) ce_desc(v[B + a], v[B + b]);
    S16(0,13) S16(1,12) S16(2,15) S16(3,14) S16(4,8) S16(5,6) S16(7,11) S16(9,10)
    S16(0,5) S16(1,7) S16(2,9) S16(3,4) S16(6,13) S16(8,14) S16(10,15) S16(11,12)
    S16(0,1) S16(2,3) S16(4,5) S16(6,8) S16(7,9) S16(10,11) S16(12,13) S16(14,15)
    S16(0,2) S16(1,3) S16(4,10) S16(5,11) S16(6,7) S16(8,9) S16(12,14) S16(13,15)
    S16(1,2) S16(3,12) S16(4,6) S16(5,7) S16(8,10) S16(9,11) S16(13,14)
    S16(1,4) S16(2,6) S16(5,8) S16(7,10) S16(9,13) S16(11,14)
    S16(2,4) S16(3,6) S16(9,12) S16(11,13)
    S16(3,5) S16(6,8) S16(7,9) S16(10,12)
    S16(3,4) S16(5,6) S16(7,8) S16(9,10) S16(11,12)
    S16(6,7) S16(8,9)
#undef S16
}
template <int B> __device__ __forceinline__ void bitonic_merge16(float (&v)[64]) {
#pragma unroll
    for (int j = 8; j > 0; j >>= 1)
#pragma unroll
        for (int i = 0; i < 16; ++i) { const int l = i ^ j; if (l > i) ce_desc(v[B + i], v[B + l]); }
}
template <int A, int B> __device__ __forceinline__ void merge_top16(float (&v)[64]) {
#pragma unroll
    for (int i = 0; i < 16; ++i) v[A + i] = max_asm(v[A + i], v[B + 15 - i]);
    bitonic_merge16<A>(v);
}
__device__ __forceinline__ void top16_of_64(float (&v)[64]) { sort16_desc<0>(v); sort16_desc<16>(v); sort16_desc<32>(v); sort16_desc<48>(v); merge_top16<0, 16>(v); merge_top16<32, 48>(v); merge_top16<0, 32>(v); }

__device__ __forceinline__ void p10_retrieve(const Frame& F, const Args& a) {
    unsigned char* ws = a.ws; const bf16* Q = (const bf16*)(ws + WS_Q); const bf16* KEYS = (const bf16*)(ws + WS_KEYS);
    unsigned* IDW = (unsigned*)(ws + WS_IDW);
    LAS unsigned char* kl = F.lds;
    const int h = blockIdx.x & 7, rank = blockIdx.x >> 3, nblk = (F.G - h + 7) >> 3;
    for (int pc = F.tid; pc < 2 * 128 * 16; pc += NTHREADS) { const int rowk = pc >> 4, ch = pc & 15;
        *(LAS u32x4*)(kl + rowk * KPITCH + ch * 16) = *((const u32x4*)(KEYS + (size_t)h * 2 * 128 * 128) + pc); }
    __syncthreads();
    if (F.wave < 4) convert_tables(F, a);
    const int tl = F.lane & 31, hh = F.lane >> 5;
    const unsigned hh4 = (unsigned)hh * 4u;
    bf16x8 q0[8], q1[8];
    { const size_t tok0 = (size_t)(rank * NWAVES + F.wave < M / 32 ? rank * NWAVES + F.wave : 0) * 32 + tl;
#pragma unroll
      for (int s = 0; s < 8; ++s) q0[s] = *(const bf16x8*)(Q + tok0 * 2048 + h * 256 + 16 * s + 8 * hh); }
#pragma unroll 1
    for (int grp = rank * NWAVES + F.wave; grp < M / 32; grp += nblk * NWAVES) {
        const size_t tok = (size_t)grp * 32 + tl;
        const int gn = grp + nblk * NWAVES; const size_t tokn = (size_t)(gn < M / 32 ? gn : grp) * 32 + tl;
        float res[2][16];
#pragma unroll
        for (int p = 0; p < 2; ++p) {
            bf16x8 qc[8];
#pragma unroll
            for (int s = 0; s < 8; ++s) qc[s] = p ? q1[s] : q0[s];
            if (p == 0) {
#pragma unroll
                for (int s = 0; s < 8; ++s) q1[s] = *(const bf16x8*)(Q + tok * 2048 + h * 256 + 128 + 16 * s + 8 * hh);
            } else {
#pragma unroll
                for (int s = 0; s < 8; ++s) q0[s] = *(const bf16x8*)(Q + tokn * 2048 + h * 256 + 16 * s + 8 * hh);
            }
            f32x16 acc[4];
#pragma unroll
            for (int kb = 0; kb < 4; ++kb)
#pragma unroll
                for (int r = 0; r < 16; ++r) acc[kb][r] = 0.f;
#pragma unroll
            for (int s = 0; s < 8; ++s)
#pragma unroll
                for (int kb = 0; kb < 4; ++kb) { const bf16x8 kf = *(const LAS bf16x8*)(kl + (p * 128 + kb * 32 + tl) * KPITCH + (16 * s + 8 * hh) * 2);
                    acc[kb] = __builtin_amdgcn_mfma_f32_32x32x16_bf16(kf, qc[s], acc[kb], 0, 0, 0); }
            float v[64];
#pragma unroll
            for (int kb = 0; kb < 4; ++kb)
#pragma unroll
                for (int r = 0; r < 16; ++r) v[kb * 16 + r] = __uint_as_float(((__float_as_uint(acc[kb][r]) & 0xFFFFFF80u) | hh4) | (unsigned)(32 * kb + 8 * (r >> 2) + (r & 3)));
            top16_of_64(v);
#pragma unroll
            for (int i = 0; i < 16; ++i) {
                auto rr = __builtin_amdgcn_permlane32_swap(__float_as_uint(v[15 - i]), __float_as_uint(v[15 - i]), false, false);
                const float partner = __uint_as_float(hh ? rr[0] : rr[1]);
                v[16 + i] = max_asm(v[i], partner); }
            bitonic_merge16<16>(v);
#pragma unroll
            for (int i = 0; i < 16; ++i) res[p][i] = v[16 + i];
            __builtin_amdgcn_sched_barrier(0);
        }
        float v[64]; unsigned i0[16], j1[16];
#pragma unroll
        for (int i = 0; i < 16; ++i) { i0[i] = (__float_as_uint(res[0][i]) & 127u) << 7; j1[i] = __float_as_uint(res[1][i]) & 127u; }
        { int n = 0;
#pragma unroll
          for (int i = 0; i < 16; ++i)
#pragma unroll
              for (int j = 0; j < 16; ++j) if ((i + 1) * (j + 1) <= 16) { v[n] = __uint_as_float((__float_as_uint(res[0][i] + res[1][j]) & 0xFFFFC000u) | i0[i] | j1[j]); ++n; }
#pragma unroll
          for (int q = 50; q < 64; ++q) v[q] = -INFINITY; }
        top16_of_64(v);
        float e[16], sum = 0.f; const float mx = __uint_as_float(__float_as_uint(v[0]) & 0xFFFFC000u);
#pragma unroll
        for (int r = 0; r < 16; ++r) { e[r] = fast_exp(__uint_as_float(__float_as_uint(v[r]) & 0xFFFFC000u) - mx); sum += e[r]; }
        const float inv = 1.f / sum;
        {
            u32x4* o = (u32x4*)(IDW + tok * NSEL + h * 16 + 8 * hh);
#pragma unroll
            for (int q = 0; q < 2; ++q) { u32x4 w4;
#pragma unroll
                for (int c = 0; c < 4; ++c) { const float va = v[4 * q + c], vb = v[8 + 4 * q + c]; const float ea = e[4 * q + c], eb = e[8 + 4 * q + c];
                    const float vv = hh ? vb : va, ee = hh ? eb : ea; w4[c] = ((__float_as_uint(vv) & 0x3FFFu) << 16) | (cvt_pk_bf16(ee * inv, 0.f) & 0xFFFFu); }
                o[q] = w4; } }
    }
    if (F.wave >= 4) convert_tables(F, a);
}

typedef int i32x4 __attribute__((ext_vector_type(4)));
template <int CTRL> __device__ __forceinline__ int dpp_i(int v) { return __builtin_amdgcn_update_dpp(0, v, CTRL, 0xf, 0xf, true); }
struct URaw { unsigned xa, xb; u32x4 h; float sh; int tok; };
struct UMeta8 { int idv, kv, n; float wv, su, sv, sh; u32x4 h; int tok; };
__device__ __forceinline__ void u_prep(URaw& r, int tok, const unsigned* IDW, const unsigned char* H8, const float* SH, int lane) {
    r.tok = tok; const size_t tc = (size_t)(tok < M ? tok : M - 1);
    r.xa = IDW[tc * NSEL + lane]; r.xb = IDW[tc * NSEL + 64 + lane];
    r.h = *((const u32x4*)(H8 + tc * D) + lane); r.sh = SH[tc]; }
__device__ __forceinline__ void u_fetch(UMeta8& m, LAS i32x4* slots, int base, int lane16or32, const LAS unsigned* SUV) {
    const i32x4 e = slots[base + lane16or32]; const bool valid = base + lane16or32 < m.n;
    m.idv = valid ? (int)((unsigned)e.x >> 16) : 0; m.wv = valid ? __uint_as_float((unsigned)e.x << 16) : 0.f; m.kv = e.z; { const unsigned sc = SUV[m.idv & 2047]; m.su = bf_lo(sc); m.sv = bf_hi(sc); } }
__device__ __forceinline__ void u_compact(const URaw& r, UMeta8& m, LAS i32x4* slots, int label, const LAS unsigned* SUV, int lane) {
    const bool ina = (int)(r.xa >> 27) == label, inb = (int)(r.xb >> 27) == label;
    const unsigned long long ma = __ballot(ina), mb = __ballot(inb); const int na = __popcll(ma); m.n = na + __popcll(mb);
    const int ra = __builtin_amdgcn_mbcnt_hi((unsigned)(ma >> 32), __builtin_amdgcn_mbcnt_lo((unsigned)ma, 0)), rb = na + __builtin_amdgcn_mbcnt_hi((unsigned)(mb >> 32), __builtin_amdgcn_mbcnt_lo((unsigned)mb, 0));
    if (ina) slots[ra] = (i32x4){(int)r.xa, 0, lane, 0}; if (inb) slots[rb] = (i32x4){(int)r.xb, 0, 64 + lane, 0};
    m.h = r.h; m.sh = r.sh; m.tok = r.tok;
    u_fetch(m, slots, 0, lane & 31, SUV); }
template <int S0> __device__ __forceinline__ void u_issue16(int idv, int n, u32x4 (&buf)[16], const unsigned char* U8, int lane) {
#pragma unroll
    for (int s = 0; s < 16; ++s) if (S0 + s < n) { const int id = __builtin_amdgcn_readlane(idv, S0 + s); buf[s] = *((const u32x4*)(U8 + (size_t)id * D) + lane); }
}
__device__ __forceinline__ int u_dot16(const u32x4 (&buf)[16], const u32x4 h, int lane) {
    int d[16];
#pragma unroll
    for (int s = 0; s < 16; ++s) { int t = __builtin_amdgcn_sdot4((int)buf[s].x, (int)h.x, 0, false); t = __builtin_amdgcn_sdot4((int)buf[s].y, (int)h.y, t, false);
        t = __builtin_amdgcn_sdot4((int)buf[s].z, (int)h.z, t, false); d[s] = __builtin_amdgcn_sdot4((int)buf[s].w, (int)h.w, t, false); }
    const bool b0 = lane & 1, b1 = lane & 2, b2 = lane & 4, b3 = lane & 8;
    int r1[8], r2[4], r3[2];
#pragma unroll
    for (int p = 0; p < 8; ++p) { const int keep = b0 ? d[2 * p + 1] : d[2 * p], send = b0 ? d[2 * p] : d[2 * p + 1]; r1[p] = keep + dpp_i<0xB1>(send); }
#pragma unroll
    for (int p = 0; p < 4; ++p) { const int keep = b1 ? r1[2 * p + 1] : r1[2 * p], send = b1 ? r1[2 * p] : r1[2 * p + 1]; r2[p] = keep + dpp_i<0x4E>(send); }
#pragma unroll
    for (int p = 0; p < 2; ++p) { const int keep = b2 ? r2[2 * p + 1] : r2[2 * p], send = b2 ? r2[2 * p] : r2[2 * p + 1]; r3[p] = keep + __builtin_amdgcn_ds_swizzle(send, 0x101F); }
    int r4; { const int keep = b3 ? r3[1] : r3[0], send = b3 ? r3[0] : r3[1]; r4 = keep + dpp_i<0x128>(send); }
    { auto q = __builtin_amdgcn_permlane16_swap((unsigned)r4, (unsigned)r4, false, false); r4 = (int)q[0] + (int)q[1]; }
    { auto q = __builtin_amdgcn_permlane32_swap((unsigned)r4, (unsigned)r4, false, false); r4 = (int)q[0] + (int)q[1]; }
    return r4; }
__device__ __forceinline__ float u_z(const UMeta8& m, int d) { return gelu_tanh((float)d * m.su * m.sh) * m.wv * m.sv; }
__device__ __forceinline__ void p11_expert_u(const Frame& F, const Args& a) {
    unsigned char* ws = a.ws; const unsigned* IDW = (const unsigned*)(ws + WS_IDW);
    const unsigned char* U8 = ws + WS_U8; const unsigned char* H8 = ws + WS_H8; const unsigned* SUVg = (const unsigned*)(ws + WS_SU); const float* SH = (const float*)(ws + WS_SH);
    unsigned* ZI = (unsigned*)(ws + WS_ZI);
    const int label = blockIdx.x & 7, rank = blockIdx.x >> 3, nblk = (F.G - label + 7) >> 3, widx = rank * NWAVES + F.wave, wstride = nblk * NWAVES;
    const int T = (M - widx + wstride - 1) / wstride;
    LAS i32x4* slot0 = (LAS i32x4*)(F.lds + F.wave * 4096);
    LAS unsigned* SUV = (LAS unsigned*)(F.lds + 32768);
    for (int i = F.tid; i < 2048; i += NTHREADS) SUV[i] = SUVg[label * 2048 + i];
    __syncthreads();
#define U_TOK(q) ((q) < T ? widx + (q) * wstride : M)
    URaw rw; UMeta8 mc, mn; u32x4 bA[16], bB[16];
#pragma unroll
    for (int s = 0; s < 16; ++s) { bA[s] = (u32x4){0u, 0u, 0u, 0u}; bB[s] = bA[s]; }
    u_prep(rw, U_TOK(0), IDW, H8, SH, F.lane);
    u_compact(rw, mc, slot0, label, SUV, F.lane);
    u_prep(rw, U_TOK(1), IDW, H8, SH, F.lane);
    u_issue16<0>(mc.idv, mc.n, bA, U8, F.lane); u_issue16<16>(mc.idv, mc.n, bB, U8, F.lane);
#pragma unroll 1
    for (int q = 0; q < T; ++q) {
        LAS i32x4* scur = slot0 + (q & 1) * 128; LAS i32x4* snxt = slot0 + ((q + 1) & 1) * 128;
        u_compact(rw, mn, snxt, label, SUV, F.lane);
        u_prep(rw, U_TOK(q + 2), IDW, H8, SH, F.lane);
        const int dA = u_dot16(bA, mc.h, F.lane);
        u_issue16<0>(mn.idv, mn.n, bA, U8, F.lane);
        int dB = 0; if (mc.n > 16) dB = u_dot16(bB, mc.h, F.lane);
        u_issue16<16>(mn.idv, mn.n, bB, U8, F.lane);
        { const float z = u_z(mc, (F.lane & 16) ? dB : dA); if (mc.tok < M && F.lane < (mc.n < 32 ? mc.n : 32)) ZI[(size_t)mc.tok * NSEL + mc.kv] = ((unsigned)mc.idv << 16) | (cvt_pk_bf16(z, 0.f) & 0xFFFFu); }
#pragma unroll 1
        for (int base = 32; base < mc.n; base += 16) {
            UMeta8 mo = mc; u_fetch(mo, scur, base, F.lane & 15, SUV); u32x4 bx[16]; u_issue16<0>(mo.idv, 16, bx, U8, F.lane);
            const int dx = u_dot16(bx, mc.h, F.lane); const float z = u_z(mo, dx);
            if (mc.tok < M && F.lane < 16 && base + F.lane < mc.n) ZI[(size_t)mc.tok * NSEL + mo.kv] = ((unsigned)mo.idv << 16) | (cvt_pk_bf16(z, 0.f) & 0xFFFFu); }
        mc = mn;
    }
#undef U_TOK
}
struct VMeta { unsigned xa, xb; int tok; };
struct VBatch { u32x4 pc[16]; };
__device__ __forceinline__ void v_load_meta(VMeta& m, int tok, const unsigned* ZI, int lane) {
    m.tok = tok; const size_t tc = (size_t)(tok < M ? tok : M - 1);
    m.xa = ZI[tc * NSEL + lane]; m.xb = ZI[tc * NSEL + 64 + lane]; }
__device__ __forceinline__ void v_issue(const VMeta& m, int cs, VBatch& b, const unsigned char* V8, int sub, int grp) {
#pragma unroll
    for (int i = 0; i < 16; ++i) { const int src = (8 * i + grp) & 63; const int id = (int)(((i < 8) ? (unsigned)__shfl((int)m.xa, src) : (unsigned)__shfl((int)m.xb, src)) >> 16);
        b.pc[i] = *(const u32x4*)(V8 + (size_t)id * D + cs * 128 + sub * 16); }
}
__device__ __forceinline__ void v_compute(const VMeta& m, int cs, const VBatch& b, bf16* out, int sub, int grp, int lane) {
    const float za = __uint_as_float(m.xa << 16), zb = __uint_as_float(m.xb << 16);
    const float cmax = wave_max(fmaxf(fabsf(za), fabsf(zb))); const float inv = cmax > 0.f ? 127.f / cmax : 0.f, sct = cmax * (1.f / 127.f);
    const int cqa = (int)__builtin_rintf(za * inv) & 255, cqb = (int)__builtin_rintf(zb * inv) & 255;
    int acc[16];
#pragma unroll
    for (int e = 0; e < 16; ++e) acc[e] = 0;
#pragma unroll
    for (int a4 = 0; a4 < 4; ++a4) {
        unsigned C = 0u;
#pragma unroll
        for (int j = 0; j < 4; ++j) { const int src = (32 * a4 + 8 * j + grp) & 63; const unsigned g = (unsigned)((a4 < 2) ? __shfl(cqa, src) : __shfl(cqb, src)); C |= g << (8 * j); }
#pragma unroll
        for (int d = 0; d < 4; ++d) { const unsigned W0 = b.pc[4 * a4][d], W1 = b.pc[4 * a4 + 1][d], W2 = b.pc[4 * a4 + 2][d], W3 = b.pc[4 * a4 + 3][d];
            const unsigned P01l = __builtin_amdgcn_perm(W1, W0, 0x05010400u), P01h = __builtin_amdgcn_perm(W1, W0, 0x07030602u);
            const unsigned P23l = __builtin_amdgcn_perm(W3, W2, 0x05010400u), P23h = __builtin_amdgcn_perm(W3, W2, 0x07030602u);
            const unsigned T0 = __builtin_amdgcn_perm(P23l, P01l, 0x05040100u), T1 = __builtin_amdgcn_perm(P23l, P01l, 0x07060302u);
            const unsigned T2 = __builtin_amdgcn_perm(P23h, P01h, 0x05040100u), T3 = __builtin_amdgcn_perm(P23h, P01h, 0x07060302u);
            acc[4 * d] = __builtin_amdgcn_sdot4((int)T0, (int)C, acc[4 * d], false); acc[4 * d + 1] = __builtin_amdgcn_sdot4((int)T1, (int)C, acc[4 * d + 1], false);
            acc[4 * d + 2] = __builtin_amdgcn_sdot4((int)T2, (int)C, acc[4 * d + 2], false); acc[4 * d + 3] = __builtin_amdgcn_sdot4((int)T3, (int)C, acc[4 * d + 3], false); } }
    const bool b3 = grp & 1;
#define V_L1(lo, hi) ((b3 ? acc[hi] : acc[lo]) + dpp_i<0x128>(b3 ? acc[lo] : acc[hi]))
    const int r1_0 = V_L1(0, 2), r1_1 = V_L1(1, 3), r1_2 = V_L1(4, 6), r1_3 = V_L1(5, 7), r1_4 = V_L1(8, 10), r1_5 = V_L1(9, 11), r1_6 = V_L1(12, 14), r1_7 = V_L1(13, 15);
#undef V_L1
#define V_SW16(x, y, o) int o; { auto q = __builtin_amdgcn_permlane16_swap((unsigned)(x), (unsigned)(y), false, false); o = (int)q[0] + (int)q[1]; }
#define V_SW32(x, y, o) int o; { auto q = __builtin_amdgcn_permlane32_swap((unsigned)(x), (unsigned)(y), false, false); o = (int)q[0] + (int)q[1]; }
    V_SW16(r1_0, r1_2, r2_0) V_SW16(r1_1, r1_3, r2_1) V_SW16(r1_4, r1_6, r2_2) V_SW16(r1_5, r1_7, r2_3)
    V_SW32(r2_0, r2_2, r3_0) V_SW32(r2_1, r2_3, r3_1)
#undef V_SW16
#undef V_SW32
    if (m.tok < M) *(unsigned*)(out + (size_t)m.tok * D + cs * 128 + sub * 16 + 2 * grp) = cvt_pk_bf16((float)r3_0 * sct, (float)r3_1 * sct);
}
__device__ __forceinline__ void p12_expert_v(const Frame& F, const Args& a) {
    unsigned char* ws = a.ws; const unsigned* ZI = (const unsigned*)(ws + WS_ZI); const unsigned char* V8 = ws + WS_V8;
    const int label = blockIdx.x & 7, rank = blockIdx.x >> 3, nblk = (F.G - label + 7) >> 3, widx = rank * NWAVES + F.wave, wstride = nblk * NWAVES;
    const int sub = F.lane & 7, grp = F.lane >> 3;
    const int T = (M - widx + wstride - 1) / wstride, NQ = (T + 1) & ~1;
#define V_TOK(q) ((q) < T ? widx + (q) * wstride : M)
    VMeta mc, mn, mf; VBatch bA, bB;
    v_load_meta(mc, V_TOK(0), ZI, F.lane); v_load_meta(mn, V_TOK(1), ZI, F.lane);
    v_issue(mc, label, bA, V8, sub, grp);
#pragma unroll 1
    for (int q = 0; q < NQ; q += 2) {
        v_issue(mn, label, bB, V8, sub, grp); v_load_meta(mf, V_TOK(q + 2), ZI, F.lane); v_compute(mc, label, bA, (bf16*)(a.ws + WS_FFN), sub, grp, F.lane); mc = mn; mn = mf;
        v_issue(mn, label, bA, V8, sub, grp); v_load_meta(mf, V_TOK(q + 3), ZI, F.lane); v_compute(mc, label, bB, (bf16*)(a.ws + WS_FFN), sub, grp, F.lane); mc = mn; mn = mf;
    }
#undef V_TOK
}
__device__ __forceinline__ void p13_final(const Frame& F, const Args& a) {
    const bf16* H1 = (const bf16*)(a.ws + WS_H1); const bf16* FFN = (const bf16*)(a.ws + WS_FFN);
    u32x2 nh[4], nf[4];
#pragma unroll
    for (int j = 0; j < 4; ++j) { const size_t t0 = (size_t)(F.gw < M ? F.gw : 0); nh[j] = *((const u32x2*)(H1 + t0 * D) + F.lane + 64 * j); nf[j] = *((const u32x2*)(FFN + t0 * D) + F.lane + 64 * j); }
#pragma unroll 1
    for (int tok = F.gw; tok < M; tok += F.NGW) {
        f32x4 y[4]; const size_t tn = (size_t)(tok + F.NGW < M ? tok + F.NGW : tok);
#pragma unroll
        for (int j = 0; j < 4; ++j) { const u32x2 w = nh[j], f = nf[j];
            y[j].x = ALPHA * bf_lo(w.x) + bf_lo(f.x); y[j].y = ALPHA * bf_hi(w.x) + bf_hi(f.x); y[j].z = ALPHA * bf_lo(w.y) + bf_lo(f.y); y[j].w = ALPHA * bf_hi(w.y) + bf_hi(f.y);
            nh[j] = *((const u32x2*)(H1 + tn * D) + F.lane + 64 * j); nf[j] = *((const u32x2*)(FFN + tn * D) + F.lane + 64 * j); }
        ln_vals(y, a.in[I_LN2G], a.in[I_LN2B], F.lane);
#pragma unroll
        for (int j = 0; j < 4; ++j) *((f32x4*)(a.out + (size_t)tok * D) + F.lane + 64 * j) = y[j];
    }
}

__device__ __forceinline__ void g1a_inproj(const Frame& F, const Args& a) { unsigned char* ws = a.ws;
    const bf16* WT = (const bf16*)(ws + WS_WINT); unsigned char* WG8 = ws + WS_WG8; float* SB = (float*)(ws + WS_SB);
    for (int r = F.gw; r < NPROJ; r += F.NGW) { f32x4 v[4];
#pragma unroll
        for (int j = 0; j < 4; ++j) { const u32x2 w = *((const u32x2*)(WT + (size_t)r * 1024) + F.lane + 64 * j); v[j] = (f32x4){bf_lo(w.x), bf_hi(w.x), bf_lo(w.y), bf_hi(w.y)}; }
        const float am = fmaxf(absmax4(v), 1e-20f), inv = 127.f / am;
#pragma unroll
        for (int j = 0; j < 4; ++j) *((unsigned*)(WG8 + (size_t)r * 1024) + F.lane + 64 * j) = pack_i8x4(v[j], inv);
        if (F.lane == 0) SB[r] = am * (1.f / 127.f); } }
__device__ __forceinline__ void g1b_inproj(const Frame& F, const Args& a) { unsigned char* ws = a.ws; pg8::StaticOrder S;
    pg8::Gemm g{(const char*)(ws + WS_H0Q), (const char*)(ws + WS_WG8), 512u, 512u, 8, 256, 18, -1}; S.init(256, 18, F.G, blockIdx.x);
    pg8::EpiInProjSig8 E{(bf16*)(ws + WS_XR), (bf16*)(ws + WS_ACAT), (bf16*)(ws + WS_XP), (bf16*)(ws + WS_GL), (const float*)(ws + WS_SA), (const float*)(ws + WS_SB)};
    pg8::gemm_phase<pg8::EpiInProjSig8, true, true, -1, true>(F.lds, g, S, E); }
__device__ __forceinline__ void g3_gate(const Frame& F, const Args& a) { unsigned char* ws = a.ws; pg8::StaticOrder S;
    pg8::Gemm g{(const char*)(ws + WS_XC), (const char*)(ws + WS_GATET), 1024u, 256u, 4, 256, 8, 1}; S.init(256, 8, F.G, blockIdx.x);
    pg8::EpiGate E{(const bf16*)(ws + WS_XC), a.in[I_BRG], a.in[I_BIG], (const float*)(ws + WS_LS8), (bf16*)(ws + WS_LOGA), (bf16*)(ws + WS_BB)};
    pg8::gemm_phase<pg8::EpiGate, true, true>(F.lds, g, S, E); }
__device__ __forceinline__ void g6_merge(const Frame& F, const Args& a) { unsigned char* ws = a.ws; pg8::StaticOrder S; S.init(256, 4, F.G, blockIdx.x);
    pg8::Gemm g{(const char*)(ws + WS_ACAT), (const char*)(ws + WS_BCAT), 1536u, 1536u, 24, 256, 4, -1};
    pg8::EpiMerge E{(const bf16*)(ws + WS_GL), (bf16*)(ws + WS_MERGED)};
    pg8::gemm_phase<pg8::EpiMerge, true, true, 8>(F.lds, g, S, E); }
__device__ __forceinline__ void g7_out(const Frame& F, const Args& a) { unsigned char* ws = a.ws; pg8::StaticOrder S;
    pg8::Gemm g{(const char*)(ws + WS_MERGED), (const char*)(ws + WS_WOUTT), 1024u, 1024u, 16, 256, 4, -1}; S.init(256, 4, F.G, blockIdx.x);
    pg8::EpiOut E{(const bf16*)(ws + WS_H0), (bf16*)(ws + WS_V1)};
    pg8::gemm_phase<pg8::EpiOut, true, true>(F.lds, g, S, E); }
__device__ __forceinline__ void g9_q(const Frame& F, const Args& a) { unsigned char* ws = a.ws; pg8::StaticOrder S;
    pg8::Gemm g{(const char*)(ws + WS_H8), (const char*)(ws + WS_WQ8), 512u, 512u, 8, 256, 8, -1}; S.init(256, 8, F.G, blockIdx.x);
    pg8::EpiQ8 E{(bf16*)(ws + WS_Q), (const float*)(ws + WS_SH), (const float*)(ws + WS_SQ)};
    pg8::gemm_phase<pg8::EpiQ8, true, true, -1, true>(F.lds, g, S, E); }

__global__ void __launch_bounds__(NTHREADS, 2) fwd_kernel(Args a) {
    extern __shared__ __attribute__((aligned(16))) unsigned char lds_raw[];
    Frame F; F.lds = (LAS unsigned char*)lds_raw; F.tid = threadIdx.x; F.lane = F.tid & 63; F.wave = __builtin_amdgcn_readfirstlane(F.tid >> 6); F.G = gridDim.x;
    F.gw = blockIdx.x * NWAVES + F.wave; F.NGW = F.G * NWAVES;
    unsigned char* ws = a.ws;
    const int lo = a.ph_lo, hi = a.ph_hi;
    volatile LAS unsigned* misc = (volatile LAS unsigned*)(F.lds + 131072);
    if (F.tid < 4) misc[F.tid] = 0u;
    __syncthreads();
    if (a.ph_lo < 0) cg::this_grid().sync();
    XcdBarrier xbar = xcd_barrier_post((unsigned*)(ws + WS_CTL) + 4096, misc);
#ifndef REP_MASK
#define REP_MASK 0
#endif
#define IN(k) (lo <= (k) && (k) < hi)
#define REP(k) ((REP_MASK >> (k)) & 1)
#define SEAM(k) do { if (IN(k) && IN((k) + 1)) { xcd_barrier(xbar); } } while (0)
    if (IN(0)) { p0_prologue(F, a); if (REP(0)) p0_prologue(F, a); } SEAM(0);
    if (IN(1)) { g1a_inproj(F, a); xcd_barrier(xbar); g1b_inproj(F, a); } SEAM(1);
    if (IN(2)) { p2_convpool(F, a); if (REP(2)) p2_convpool(F, a); } SEAM(2);
    if (IN(3)) { g3_gate(F, a); if (REP(3)) g3_gate(F, a); } SEAM(3);
    if (IN(4)) { p4_scan_agg(F, a); if (REP(4)) p4_scan_agg(F, a); } SEAM(4);
    if (IN(5)) { p5_scan_apply(F, a); if (REP(5)) p5_scan_apply(F, a); } SEAM(5);
    if (IN(6)) { g6_merge(F, a); if (REP(6)) g6_merge(F, a); } SEAM(6);
    if (IN(7)) { g7_out(F, a); if (REP(7)) g7_out(F, a); } SEAM(7);
    if (IN(8)) { p8_ln1(F, a); if (REP(8)) p8_ln1(F, a); } SEAM(8);
    if (IN(9)) { g9_q(F, a); if (REP(9)) g9_q(F, a); } SEAM(9);
    if (IN(10)) { p10_retrieve(F, a); if (REP(10)) p10_retrieve(F, a); } SEAM(10);
    if (IN(11)) { p11_expert_u(F, a); if (REP(11)) p11_expert_u(F, a); } SEAM(11);
    if (IN(12)) { p12_expert_v(F, a); if (REP(12)) p12_expert_v(F, a); } SEAM(12);
    if (IN(13)) { p13_final(F, a); }
#undef IN
#undef SEAM
}

extern "C" void kernel_launch(void* const* d_in, const int* in_sizes, int n_in, void* d_out, int out_size, void* d_ws, size_t ws_size, hipStream_t stream) {
    static int grid = 0;
    if (grid == 0) {
        if (n_in != 25 || in_sizes[0] != M * D || out_size != M * D || ws_size < WS_END) { fprintf(stderr, "kernel_launch: unexpected shapes: n_in %d in0 %d out %d ws %zu\n", n_in, n_in > 0 ? in_sizes[0] : -1, out_size, ws_size); grid = -1; return; }
        int dev = 0, cus = 0, per_cu = 0;
        hipGetDevice(&dev); hipDeviceGetAttribute(&cus, hipDeviceAttributeMultiprocessorCount, dev);
        if (hipFuncSetAttribute((const void*)fwd_kernel, hipFuncAttributeMaxDynamicSharedMemorySize, LDS_BYTES) != hipSuccess) { fprintf(stderr, "kernel_launch: hipFuncSetAttribute failed\n"); grid = -1; return; }
        if (hipOccupancyMaxActiveBlocksPerMultiprocessor(&per_cu, (const void*)fwd_kernel, NTHREADS, LDS_BYTES) != hipSuccess || per_cu < 1) { fprintf(stderr, "kernel_launch: occupancy query says %d\n", per_cu); per_cu = 1; }
        (void)hipGetLastError();
        grid = cus;
        fprintf(stderr, "kernel_launch: grid %d (occupancy query %d per CU)\n", grid, per_cu);
    }
    if (grid < 0) return;
    if (hipMemsetAsync((char*)d_ws + WS_CTL, 0, 65536, stream) != hipSuccess) { fprintf(stderr, "kernel_launch: hipMemsetAsync failed\n"); return; }
    Args a{};
    for (int i = 0; i < 25; ++i) a.in[i] = (const float*)d_in[i];
    a.out = (float*)d_out; a.ws = (unsigned char*)d_ws;
#if MK_ONE_LAUNCH
    a.ph_lo = 0; a.ph_hi = NPHASES;
    { void* args[] = {&a}; hipError_t e = hipLaunchCooperativeKernel((const void*)fwd_kernel, dim3(grid), dim3(NTHREADS), args, LDS_BYTES, stream);
      if (e != hipSuccess) fprintf(stderr, "kernel_launch: cooperative launch failed: %s\n", hipGetErrorString(e)); }
#else
    for (int p = 0; p < NPHASES; ++p) { a.ph_lo = p; a.ph_hi = p + 1; void* args[] = {&a};
        hipError_t e = hipLaunchCooperativeKernel((const void*)fwd_kernel, dim3(grid), dim3(NTHREADS), args, LDS_BYTES, stream);
        if (e != hipSuccess) { fprintf(stderr, "kernel_launch: launch %d failed: %s\n", p, hipGetErrorString(e)); break; } }
#endif
}
```

```cpp
#include <hip/hip_runtime.h>
#include <hip/hip_cooperative_groups.h>
#include <cstdio>
#include <cstdint>
namespace cg = cooperative_groups;

#ifndef MK_ONE_LAUNCH
#define MK_ONE_LAUNCH 1
#endif

#define LAS __attribute__((address_space(3)))
typedef unsigned short bf16;
typedef unsigned u32x4 __attribute__((ext_vector_type(4)));
typedef unsigned u32x2 __attribute__((ext_vector_type(2)));
typedef float f32x4 __attribute__((ext_vector_type(4)));
typedef float f32x2 __attribute__((ext_vector_type(2)));
typedef short bf16x8 __attribute__((ext_vector_type(8)));

constexpr int NB = 8, SEQ = 8192, D = 1024, M = NB * SEQ, NMETA = 16, NPROJ = 4608, DPOOL = 512;
constexpr int PH = 8, PKEYS = 128, NSEL = 128;
constexpr float ALPHA = 1.189207115002721f, LN_EPS = 1e-5f, LOG2E = 1.4426950408889634f;
constexpr int NWAVES = 8, NTHREADS = 512;
constexpr int LDS_BYTES = 131072 + 1024 + 16384;

constexpr size_t MiB = 1u << 20;
constexpr size_t WS_CTL = 0;
constexpr size_t WS_PROJM = 1 * MiB;
constexpr size_t WS_HMETA = 1 * MiB + 128 * 1024;
constexpr size_t WS_LS8 = 1 * MiB + 192 * 1024;
constexpr size_t WS_AGG = 2 * MiB;
constexpr size_t WS_SUBAGG = 4 * MiB;
constexpr size_t WS_WCOMBF = 12 * MiB;
constexpr size_t WS_KEYS = 14 * MiB;
constexpr size_t WS_GATET = 15 * MiB;
constexpr size_t WS_WINT = 16 * MiB;
constexpr size_t WS_BCAT = 25 * MiB;
constexpr size_t WS_WOUTT = 28 * MiB;
constexpr size_t WS_WQT = 30 * MiB;
constexpr size_t WS_H0 = 34 * MiB;
constexpr size_t WS_ACAT = 162 * MiB;
constexpr int ACAT_LD = 1536;
constexpr size_t WS_H1 = WS_ACAT;
constexpr size_t WS_GL = 354 * MiB;
constexpr size_t WS_V1 = WS_GL;
constexpr size_t WS_FFN = WS_GL + 128 * MiB;
constexpr size_t WS_XC = 610 * MiB;
constexpr size_t WS_XR = 738 * MiB;
constexpr size_t WS_LOGA = WS_XR;
constexpr size_t WS_MERGED = WS_XR;
constexpr size_t WS_XP = 866 * MiB;
constexpr size_t WS_BB = WS_XP;
constexpr size_t WS_Q = 546 * MiB;
constexpr size_t WS_IDW = 802 * MiB;
constexpr size_t WS_U8 = 866 * MiB;
constexpr size_t WS_V8 = 882 * MiB;
constexpr size_t WS_H8 = 898 * MiB;
constexpr size_t WS_ZI = 962 * MiB;
constexpr size_t WS_SU = 994 * MiB;
constexpr size_t WS_SH = 994 * MiB + 131072;
constexpr size_t WS_H0Q = 610 * MiB;
constexpr size_t WS_SA = 995 * MiB;
constexpr size_t WS_WG8 = 996 * MiB;
constexpr size_t WS_SB = 1001 * MiB;
constexpr size_t WS_WQ8 = 1002 * MiB;
constexpr size_t WS_SQ = 1004 * MiB;
constexpr size_t WS_END = 1024 * MiB;

typedef __bf16 bf16x2_cv __attribute__((ext_vector_type(2)));
__device__ __forceinline__ unsigned cvt_pk_bf16(float lo, float hi) { const f32x2 v = {lo, hi}; return __builtin_bit_cast(unsigned, __builtin_convertvector(v, bf16x2_cv)); }
__device__ __forceinline__ float bf_lo(unsigned u) { return __uint_as_float(u << 16); }
__device__ __forceinline__ float bf_hi(unsigned u) { return __uint_as_float(u & 0xffff0000u); }
__device__ __forceinline__ float fast_exp(float x) { return __builtin_amdgcn_exp2f(x * LOG2E); }
__device__ __forceinline__ float sigmoidf_(float x) { return __builtin_amdgcn_rcpf(1.f + fast_exp(-x)); }
__device__ __forceinline__ float gelu_tanh(float x) { const float u2 = 1.5957691216057308f * x * (1.f + 0.044715f * x * x); return x * __builtin_amdgcn_rcpf(1.f + fast_exp(-u2)); }
template <int CTRL> __device__ __forceinline__ float dpp_f(float v) { return __builtin_bit_cast(float, __builtin_amdgcn_update_dpp(0, __builtin_bit_cast(int, v), CTRL, 0xf, 0xf, true)); }
__device__ __forceinline__ float wave_sum(float v) {
    v += dpp_f<0xB1>(v); v += dpp_f<0x4E>(v); v += dpp_f<0x141>(v); v += dpp_f<0x140>(v);
    { auto q = __builtin_amdgcn_permlane16_swap(__float_as_uint(v), __float_as_uint(v), false, false); v = __uint_as_float(q[0]) + __uint_as_float(q[1]); }
    { auto q = __builtin_amdgcn_permlane32_swap(__float_as_uint(v), __float_as_uint(v), false, false); v = __uint_as_float(q[0]) + __uint_as_float(q[1]); }
    return v; }
__device__ __forceinline__ float wave_max(float v) {
    v = fmaxf(v, dpp_f<0xB1>(v)); v = fmaxf(v, dpp_f<0x4E>(v)); v = fmaxf(v, dpp_f<0x141>(v)); v = fmaxf(v, dpp_f<0x140>(v));
    { auto q = __builtin_amdgcn_permlane16_swap(__float_as_uint(v), __float_as_uint(v), false, false); v = fmaxf(__uint_as_float(q[0]), __uint_as_float(q[1])); }
    { auto q = __builtin_amdgcn_permlane32_swap(__float_as_uint(v), __float_as_uint(v), false, false); v = fmaxf(__uint_as_float(q[0]), __uint_as_float(q[1])); }
    return v; }
__device__ __forceinline__ int wave_min_i(int v) {
#pragma unroll
    for (int o = 1; o < 64; o <<= 1) v = min(v, __shfl_xor(v, o));
    return v; }
__device__ __forceinline__ float wave_sum_u(float v) {
    v += dpp_f<0xB1>(v); v += dpp_f<0x4E>(v); v += dpp_f<0x141>(v); v += dpp_f<0x140>(v);
    return (__builtin_bit_cast(float, __builtin_amdgcn_readlane(__builtin_bit_cast(int, v), 0)) + __builtin_bit_cast(float, __builtin_amdgcn_readlane(__builtin_bit_cast(int, v), 16))) +
           (__builtin_bit_cast(float, __builtin_amdgcn_readlane(__builtin_bit_cast(int, v), 32)) + __builtin_bit_cast(float, __builtin_amdgcn_readlane(__builtin_bit_cast(int, v), 48))); }
typedef __bf16 bf16x2_t __attribute__((ext_vector_type(2)));
__device__ __forceinline__ float dot2bf(unsigned a, unsigned b, float c) { return __builtin_amdgcn_fdot2_f32_bf16(__builtin_bit_cast(bf16x2_t, a), __builtin_bit_cast(bf16x2_t, b), c, false); }
__device__ __forceinline__ float dot8bf(const u32x4 a, const u32x4 b, float c) { c = dot2bf(a.x, b.x, c); c = dot2bf(a.y, b.y, c); c = dot2bf(a.z, b.z, c); return dot2bf(a.w, b.w, c); }
#define LDS_WAIT() asm volatile("s_waitcnt lgkmcnt(0)" ::: "memory")
__device__ __forceinline__ void unpack8(const u32x4 w, float (&f)[8]) {
    f[0] = bf_lo(w.x); f[1] = bf_hi(w.x); f[2] = bf_lo(w.y); f[3] = bf_hi(w.y); f[4] = bf_lo(w.z); f[5] = bf_hi(w.z); f[6] = bf_lo(w.w); f[7] = bf_hi(w.w); }
__device__ __forceinline__ u32x4 pack8(const float (&f)[8]) { u32x4 w; w.x = cvt_pk_bf16(f[0], f[1]); w.y = cvt_pk_bf16(f[2], f[3]); w.z = cvt_pk_bf16(f[4], f[5]); w.w = cvt_pk_bf16(f[6], f[7]); return w; }

namespace pg8 {
constexpr int TR_BASE = 131072 + 1024;
constexpr int BM = 256, BK = 64, HALF = 128, HTB = HALF * BK * 2, STAGE_BYTES = 8 * HTB, NXCD = 8, WGM = 8;
__host__ __device__ __forceinline__ int lds_byte(int r, int c) { const int st = (r >> 4) * 2 + (c >> 5), rr = r & 15, cc = c & 31, ob = rr * 64 + cc * 2; return st * 1024 + (ob ^ (((ob >> 9) & 1) << 5)); }
__host__ __device__ __forceinline__ void stage_rc(int b, int& R, int& C) { const int st = b / 1024, sb = b % 1024, swz = sb ^ (((sb >> 9) & 1) << 5); R = (st >> 1) * 16 + swz / 64; C = (st & 1) * 32 + (swz % 64) / 2; }
__host__ __device__ __forceinline__ int perm32(int rho) { const int n = rho >> 4, i = rho & 15; return 8 * (i >> 2) + 4 * n + (i & 3); }

struct Unit { int pm, pn; };
struct Gemm { const char* A; const char* B; unsigned lda, ldb; int nt, nM, nN, a_shift; int b_gap_at = 1 << 30, b_gap_rows = 0; };
__device__ __forceinline__ const char* a_tile(const Gemm& g, const Unit& u) { size_t off = (size_t)u.pm * 256 * g.lda; if (g.a_shift >= 0) off += (size_t)(u.pn >> g.a_shift) * 256; return g.A + off * 2; }
__device__ __forceinline__ const char* b_tile(const Gemm& g, const Unit& u) { return g.B + (size_t)(u.pn * 256 + (u.pn >= g.b_gap_at ? g.b_gap_rows : 0)) * g.ldb * 2; }

struct StaticOrder {
    int nM, nN, nwg, G, c;
    __device__ void init(int nM_, int nN_, int G_, int c_) { nM = nM_; nN = nN_; nwg = nM * nN; G = G_; c = c_; }
    __device__ bool next(int i, Unit& u) const {
        const long L = (long)i * G + c; if (L >= nwg) return false;
        int wgid = (int)L; { const int q = nwg / NXCD, r = nwg % NXCD, xcd = wgid % NXCD, off = wgid / NXCD; wgid = (xcd < r ? xcd * (q + 1) : r * (q + 1) + (xcd - r) * q) + off; }
        const int nig = WGM * nN, gid = wgid / nig, fm = gid * WGM, gsz = (nM - fm) < WGM ? (nM - fm) : WGM;
        u.pm = fm + ((wgid % nig) % gsz); u.pn = (wgid % nig) / gsz; return true;
    }
};

typedef int i32x4_t __attribute__((ext_vector_type(4)));
template <bool I8> __device__ __forceinline__ f32x4 mma16(const bf16x8 b, const bf16x8 a, const f32x4 c) {
    if constexpr (I8) return __builtin_bit_cast(f32x4, __builtin_amdgcn_mfma_i32_16x16x64_i8(__builtin_bit_cast(i32x4_t, b), __builtin_bit_cast(i32x4_t, a), __builtin_bit_cast(i32x4_t, c), 0, 0, 0));
    else return __builtin_amdgcn_mfma_f32_16x16x32_bf16(b, a, c, 0, 0, 0);
}
template <class Epi, bool ALIGN_EPI, bool SP2, int HOOK_T = -1, bool I8 = false>
__device__ __forceinline__ void gemm_phase(LAS unsigned char* lds, const Gemm g, const StaticOrder& S, const Epi& E) {
    const int tid = threadIdx.x, wid = __builtin_amdgcn_readfirstlane(tid >> 6), lane = tid & 63, wr = wid >> 2, wc = wid & 3, fr = lane & 15, fq = lane >> 4;
    const int nt = g.nt;
    unsigned voffA[2], voffB[2];
#pragma unroll
    for (int i = 0; i < 2; ++i) { int R, C; stage_rc(tid * 16 + i * 8192, R, C); const int Rb = (R & ~31) + perm32(R & 31);
        voffA[i] = (unsigned)(R * g.lda + C) * 2u; voffB[i] = (unsigned)(Rb * g.ldb + C) * 2u; }
    const size_t kstep = (size_t)(BK * 2);
    const size_t hstepA = (size_t)HALF * g.lda * 2, hstepB = (size_t)HALF * g.ldb * 2;
    const unsigned ldsw = (unsigned)wid * 1024u;
    const int aoff = lds_byte(wr * 64 + fr, fq * 8), boff = lds_byte(wc * 32 + fr, fq * 8);
#define PG8_SA(b, h) (((b) * 2 + (h)) * HTB)
#define PG8_SB(b, h) ((4 + (b) * 2 + (h)) * HTB)
#define PG8_STAGE(bufoff, gbase, voff) do { _Pragma("unroll") for (int _i = 0; _i < 2; ++_i) \
        __builtin_amdgcn_global_load_lds((const unsigned*)((const char*)(gbase) + (voff)[_i]), (LAS unsigned*)(lds + (bufoff) + ldsw + _i * 8192), 16, 0, 0); } while (0)
#define PG8_LDA(dst, b, h) do { _Pragma("unroll") for (int m = 0; m < 4; ++m) _Pragma("unroll") for (int k = 0; k < 2; ++k) dst[m][k] = *(const LAS bf16x8*)(lds + PG8_SA(b, h) + aoff + m * 2048 + k * 1024); } while (0)
#define PG8_LDB(dst, b, h) do { _Pragma("unroll") for (int n = 0; n < 2; ++n) _Pragma("unroll") for (int k = 0; k < 2; ++k) dst[n][k] = *(const LAS bf16x8*)(lds + PG8_SB(b, h) + boff + n * 2048 + k * 1024); } while (0)
#define PG8_MMA(ai, bj, At, Bt) do { __builtin_amdgcn_s_setprio(1); _Pragma("unroll") for (int k = 0; k < 2; ++k) _Pragma("unroll") for (int m = 0; m < 4; ++m) _Pragma("unroll") for (int n = 0; n < 2; ++n) \
        acc[ai][bj][m][n] = mma16<I8>(Bt[n][k], At[m][k], acc[ai][bj][m][n]); __builtin_amdgcn_s_setprio(0); } while (0)
#define PG8_WAIT_V(n) asm volatile("s_waitcnt vmcnt(" #n ")" ::: "memory")
#define PG8_WAIT_L(n) asm volatile("s_waitcnt lgkmcnt(" #n ")" ::: "memory")
#define PG8_BAR __builtin_amdgcn_s_barrier()
#define PG8_SCHED __builtin_amdgcn_sched_barrier(0)
    Unit cur, nxt; int ui = 0;
    if (!S.next(0, cur)) return;
    f32x4 acc[2][2][4][2];
#pragma unroll
    for (int a = 0; a < 2; ++a)
#pragma unroll
        for (int b = 0; b < 2; ++b)
#pragma unroll
            for (int m = 0; m < 4; ++m)
#pragma unroll
                for (int n = 0; n < 2; ++n) acc[a][b][m][n] = (f32x4){0.f, 0.f, 0.f, 0.f};
    bf16x8 At[4][2], B0[2][2], B1[2][2];
    const char* cA = a_tile(g, cur); const char* cB = b_tile(g, cur);
    if constexpr (SP2) {
        PG8_STAGE(PG8_SB(0, 0), cB, voffB); PG8_STAGE(PG8_SB(0, 1), cB + hstepB, voffB); PG8_STAGE(PG8_SA(0, 0), cA, voffA); PG8_STAGE(PG8_SA(0, 1), cA + hstepA, voffA);
        if (wr == 1) PG8_BAR;
        PG8_WAIT_V(2); PG8_BAR;
        PG8_STAGE(PG8_SB(1, 0), cB + kstep, voffB); PG8_STAGE(PG8_SA(1, 0), cA + kstep, voffA); PG8_STAGE(PG8_SB(1, 1), cB + hstepB + kstep, voffB);
        PG8_WAIT_V(6); PG8_BAR;
    } else {
        PG8_STAGE(PG8_SB(0, 0), cB, voffB); PG8_STAGE(PG8_SA(0, 0), cA, voffA); PG8_STAGE(PG8_SB(0, 1), cB + hstepB, voffB); PG8_STAGE(PG8_SA(0, 1), cA + hstepA, voffA);
        if (wr == 1) PG8_BAR;
        PG8_WAIT_V(4); PG8_BAR;
        PG8_STAGE(PG8_SB(1, 0), cB + kstep, voffB); PG8_STAGE(PG8_SA(1, 0), cA + kstep, voffA); PG8_STAGE(PG8_SB(1, 1), cB + hstepB + kstep, voffB);
        PG8_WAIT_V(6); PG8_BAR;
    }
    for (;;) {
        const bool has_next = S.next(ui + 1, nxt);
        const char* nA = has_next ? a_tile(g, nxt) : cA; const char* nB = has_next ? b_tile(g, nxt) : cB;
        for (int t = 0; t < nt; t += 2) {
            if constexpr (HOOK_T >= 0) { if (t == HOOK_T) E.mid(acc, cur, wr, wc, fr, fq); }
            const bool last = (t == nt - 2);
            const char* a1 = cA + (size_t)(t + 1) * kstep;
            const char* a2 = last ? nA : cA + (size_t)(t + 2) * kstep; const char* b2 = last ? nB : cB + (size_t)(t + 2) * kstep;
            const char* a3 = a2 + kstep; const char* b3 = b2 + kstep;
            if constexpr (SP2) {
            PG8_LDB(B0, 0, 0); PG8_LDB(B1, 0, 1); PG8_SCHED; PG8_LDA(At, 0, 0); PG8_STAGE(PG8_SA(1, 1), a1 + hstepA, voffA);
            PG8_WAIT_V(8); PG8_WAIT_L(0); PG8_BAR; PG8_MMA(0, 0, At, B0); PG8_MMA(0, 1, At, B1); PG8_BAR; PG8_SCHED;
            PG8_LDA(At, 0, 1); PG8_STAGE(PG8_SB(0, 0), b2, voffB); PG8_STAGE(PG8_SB(0, 1), b2 + hstepB, voffB); PG8_STAGE(PG8_SA(0, 0), a2, voffA);
            PG8_WAIT_V(8); PG8_WAIT_L(0); PG8_BAR; PG8_MMA(1, 0, At, B0); PG8_MMA(1, 1, At, B1); PG8_BAR; PG8_SCHED;
            PG8_LDB(B0, 1, 0); PG8_LDB(B1, 1, 1); PG8_SCHED; PG8_LDA(At, 1, 0); PG8_STAGE(PG8_SA(0, 1), a2 + hstepA, voffA);
            PG8_WAIT_V(8); PG8_WAIT_L(0); PG8_BAR; PG8_MMA(0, 0, At, B0); PG8_MMA(0, 1, At, B1); PG8_BAR; PG8_SCHED;
            PG8_LDA(At, 1, 1); PG8_STAGE(PG8_SB(1, 0), b3, voffB); PG8_STAGE(PG8_SB(1, 1), b3 + hstepB, voffB); PG8_STAGE(PG8_SA(1, 0), a3, voffA);
            PG8_WAIT_V(8); PG8_WAIT_L(0); PG8_BAR; PG8_MMA(1, 0, At, B0); PG8_MMA(1, 1, At, B1); PG8_BAR; PG8_SCHED;
            } else {
            PG8_LDB(B0, 0, 0); PG8_SCHED; PG8_LDA(At, 0, 0); PG8_STAGE(PG8_SA(1, 1), a1 + hstepA, voffA);
            PG8_WAIT_L(8); PG8_BAR; PG8_WAIT_L(0); PG8_MMA(0, 0, At, B0); PG8_BAR; PG8_SCHED;
            PG8_LDB(B1, 0, 1); PG8_STAGE(PG8_SB(0, 0), b2, voffB);
            PG8_BAR; PG8_WAIT_L(0); PG8_MMA(0, 1, At, B1); PG8_BAR;
            PG8_LDA(At, 0, 1); PG8_STAGE(PG8_SA(0, 0), a2, voffA);
            PG8_BAR; PG8_WAIT_L(0); PG8_MMA(1, 0, At, B0); PG8_BAR; PG8_SCHED;
            PG8_STAGE(PG8_SB(0, 1), b2 + hstepB, voffB);
            PG8_WAIT_V(6); PG8_BAR; PG8_MMA(1, 1, At, B1); PG8_BAR;
            PG8_LDB(B0, 1, 0); PG8_SCHED; PG8_LDA(At, 1, 0); PG8_STAGE(PG8_SA(0, 1), a2 + hstepA, voffA);
            PG8_WAIT_L(8); PG8_BAR; PG8_WAIT_L(0); PG8_MMA(0, 0, At, B0); PG8_BAR; PG8_SCHED;
            PG8_LDB(B1, 1, 1); PG8_STAGE(PG8_SB(1, 0), b3, voffB);
            PG8_BAR; PG8_WAIT_L(0); PG8_MMA(0, 1, At, B1); PG8_BAR;
            PG8_LDA(At, 1, 1); PG8_STAGE(PG8_SA(1, 0), a3, voffA);
            PG8_BAR; PG8_WAIT_L(0); PG8_MMA(1, 0, At, B0); PG8_BAR; PG8_SCHED;
            PG8_STAGE(PG8_SB(1, 1), b3 + hstepB, voffB);
            PG8_WAIT_V(6); PG8_BAR; PG8_MMA(1, 1, At, B1); PG8_BAR;
            }
        }
        if constexpr (ALIGN_EPI) { if (wr == 0) PG8_BAR; }
        E(acc, cur, wr, wc, fr, fq, lds + TR_BASE + wid * 2048);
        if (!has_next) break;
#pragma unroll
        for (int a = 0; a < 2; ++a)
#pragma unroll
            for (int b = 0; b < 2; ++b)
#pragma unroll
                for (int m = 0; m < 4; ++m)
#pragma unroll
                    for (int n = 0; n < 2; ++n) acc[a][b][m][n] = (f32x4){0.f, 0.f, 0.f, 0.f};
        cur = nxt; cA = nA; cB = nB; ++ui;
        if constexpr (ALIGN_EPI) { if (wr == 1) PG8_BAR; }
    }
    PG8_WAIT_V(0);
    if constexpr (!ALIGN_EPI) { if (wr == 0) PG8_BAR; }
    PG8_BAR;
#undef PG8_SA
#undef PG8_SB
#undef PG8_STAGE
#undef PG8_LDA
#undef PG8_LDB
#undef PG8_MMA
#undef PG8_WAIT_V
#undef PG8_WAIT_L
#undef PG8_BAR
#undef PG8_SCHED
}

__device__ __forceinline__ void tr_store(LAS unsigned char* trb, int slot, int fr, int fq, bf16* blk, size_t ld, const u32x4 w) {
    const int lane = fq * 16 + fr;
    *(LAS u32x4*)(trb + slot * 1024 + fr * 64 + (((fq ^ (fr >> 1)) & 3) << 4)) = w;
    asm volatile("" ::: "memory");
    const u32x4 t = *(const LAS u32x4*)(trb + slot * 1024 + lane * 16);
    *(u32x4*)(blk + (size_t)(lane >> 2) * ld + 8 * ((lane & 3) ^ ((lane >> 3) & 3))) = t;
}
#define EPI_FOR_ROWS  _Pragma("unroll") for (int ai = 0; ai < 2; ++ai) _Pragma("unroll") for (int m = 0; m < 4; ++m)
#define EPI_ROW (u.pm * 256 + ai * 128 + wr * 64 + m * 16 + fr)
#define EPI_ROW0 (u.pm * 256 + ai * 128 + wr * 64 + m * 16)
#define EPI_VALS(bj) const float v[8] = {acc[ai][bj][m][0][0], acc[ai][bj][m][0][1], acc[ai][bj][m][0][2], acc[ai][bj][m][0][3], acc[ai][bj][m][1][0], acc[ai][bj][m][1][1], acc[ai][bj][m][1][2], acc[ai][bj][m][1][3]}

struct EpiInProj {
    bf16 *XR, *XP;
    __device__ __forceinline__ void operator()(const f32x4 (&acc)[2][2][4][2], const Unit& u, int wr, int wc, int fr, int fq) const {
        bf16* base; int ld, ct;
        if (u.pn < 4) { base = XR; ld = 1024; ct = u.pn; } else { base = XP; ld = 512; ct = u.pn - 4; }
        EPI_FOR_ROWS { bf16* rowp = base + (size_t)EPI_ROW * ld + ct * 256 + wc * 32 + 8 * fq;
#pragma unroll
            for (int bj = 0; bj < 2; ++bj) { EPI_VALS(bj); *(u32x4*)(rowp + bj * 128) = pack8(v); } }
    }
};
struct EpiInProjSig {
    bf16* GL;
    __device__ __forceinline__ void operator()(const f32x4 (&acc)[2][2][4][2], const Unit& u, int wr, int wc, int fr, int fq) const {
        EPI_FOR_ROWS { bf16* rowp = GL + (size_t)EPI_ROW * 2048 + u.pn * 256 + wc * 32 + 8 * fq;
#pragma unroll
            for (int bj = 0; bj < 2; ++bj) { EPI_VALS(bj); float o[8];
#pragma unroll
                for (int e = 0; e < 8; ++e) o[e] = sigmoidf_(v[e]);
                *(u32x4*)(rowp + bj * 128) = pack8(o); } }
    }
};
struct EpiInProjSig8 {
    bf16 *XR, *ACAT, *XP, *GL; const float *SA, *SB;
    template <bool SIG> __device__ __forceinline__ void run(const f32x4 (&acc)[2][2][4][2], const Unit& u, bf16* base, int ld, int ct, const float (&sb)[2][8], int wr, int wc, int fr, int fq, LAS unsigned char* trb) const {
        float sa8[2][4];
        EPI_FOR_ROWS sa8[ai][m] = SA[EPI_ROW];
        EPI_FOR_ROWS { const float sa = sa8[ai][m]; bf16* blk = base + (size_t)EPI_ROW0 * ld + ct * 256 + wc * 32;
#pragma unroll
            for (int bj = 0; bj < 2; ++bj) { EPI_VALS(bj); float o[8];
#pragma unroll
                for (int e = 0; e < 8; ++e) { const float x = (float)__float_as_int(v[e]) * (sa * sb[bj][e]); o[e] = SIG ? sigmoidf_(x) : x; }
                tr_store(trb, bj, fr, fq, blk + bj * 128, ld, pack8(o)); } }
    }
    __device__ __forceinline__ void operator()(const f32x4 (&acc)[2][2][4][2], const Unit& u, int wr, int wc, int fr, int fq, LAS unsigned char* trb) const {
        float sb[2][8];
#pragma unroll
        for (int bj = 0; bj < 2; ++bj)
#pragma unroll
            for (int e = 0; e < 8; ++e) sb[bj][e] = SB[u.pn * 256 + bj * 128 + wc * 32 + 8 * fq + e];
        if (u.pn >= 10) run<true>(acc, u, GL, 2048, u.pn - 10, sb, wr, wc, fr, fq, trb);
        else if (u.pn < 4) run<false>(acc, u, XR, 1024, u.pn, sb, wr, wc, fr, fq, trb);
        else if (u.pn < 8) run<false>(acc, u, ACAT + 512, ACAT_LD, u.pn - 4, sb, wr, wc, fr, fq, trb);
        else run<false>(acc, u, XP, 512, u.pn - 8, sb, wr, wc, fr, fq, trb);
    }
};
struct EpiQ8 {
    bf16* Q; const float *SH, *SQ;
    __device__ __forceinline__ void operator()(const f32x4 (&acc)[2][2][4][2], const Unit& u, int wr, int wc, int fr, int fq, LAS unsigned char* trb) const {
        float sq[2][8];
#pragma unroll
        for (int bj = 0; bj < 2; ++bj)
#pragma unroll
            for (int e = 0; e < 8; ++e) sq[bj][e] = SQ[u.pn * 256 + bj * 128 + wc * 32 + 8 * fq + e];
        float sa8[2][4];
        EPI_FOR_ROWS sa8[ai][m] = SH[EPI_ROW];
        EPI_FOR_ROWS { const float sa = sa8[ai][m]; bf16* blk = Q + (size_t)EPI_ROW0 * 2048 + u.pn * 256 + wc * 32;
#pragma unroll
            for (int bj = 0; bj < 2; ++bj) { EPI_VALS(bj); float o[8];
#pragma unroll
                for (int e = 0; e < 8; ++e) o[e] = (float)__float_as_int(v[e]) * (sa * sq[bj][e]);
                tr_store(trb, bj, fr, fq, blk + bj * 128, 2048, pack8(o)); } }
    }
};
struct EpiGate {
    const bf16* XC; const float *b_rg, *b_ig, *LS8; bf16 *LOGA, *BB;
    __device__ __forceinline__ void operator()(const f32x4 (&acc)[2][2][4][2], const Unit& u, int wr, int wc, int fr, int fq, LAS unsigned char* trb) const {
        const int c0 = (u.pn >> 1) * 256 + (u.pn & 1) * 128 + wc * 32 + 8 * fq;
        f32x4 br2[2], bi2[2], ls2[2];
#pragma unroll
        for (int n = 0; n < 2; ++n) { br2[n] = *(const f32x4*)(b_rg + c0 + 4 * n); bi2[n] = *(const f32x4*)(b_ig + c0 + 4 * n); ls2[n] = *(const f32x4*)(LS8 + c0 + 4 * n); }
#pragma unroll
        for (int ai = 0; ai < 2; ++ai) {
            u32x4 xw4[4];
#pragma unroll
            for (int m = 0; m < 4; ++m) xw4[m] = *(const u32x4*)(XC + (size_t)EPI_ROW * 1024 + c0);
#pragma unroll
            for (int m = 0; m < 4; ++m) { const size_t off = (size_t)EPI_ROW * 1024 + c0; const u32x4 xw = xw4[m]; u32x4 ow_l, ow_b;
#pragma unroll
                for (int n = 0; n < 2; ++n) {
                    const f32x4 br = br2[n], bi = bi2[n], ls = ls2[n];
                    const unsigned x01 = n ? xw.z : xw.x, x23 = n ? xw.w : xw.y;
                    const float xc[4] = {bf_lo(x01), bf_hi(x01), bf_lo(x23), bf_hi(x23)};
                    float la[4], bb[4];
#pragma unroll
                    for (int e = 0; e < 4; ++e) { const float rl = acc[ai][0][m][n][e] + br[e], il = acc[ai][1][m][n][e] + bi[e];
                        const float r = sigmoidf_(rl), ig = sigmoidf_(il); const float l = ls[e] * r; const float t2 = 2.f * l;
                        const float em = (t2 > -0.02f) ? -(t2 * (1.f + t2 * (0.5f + t2 * (1.f / 6.f)))) : (1.f - fast_exp(t2));
                        la[e] = l; bb[e] = sqrtf(em) * ig * xc[e]; }
                    if (n == 0) { ow_l.x = cvt_pk_bf16(la[0], la[1]); ow_l.y = cvt_pk_bf16(la[2], la[3]); ow_b.x = cvt_pk_bf16(bb[0], bb[1]); ow_b.y = cvt_pk_bf16(bb[2], bb[3]); }
                    else { ow_l.z = cvt_pk_bf16(la[0], la[1]); ow_l.w = cvt_pk_bf16(la[2], la[3]); ow_b.z = cvt_pk_bf16(bb[0], bb[1]); ow_b.w = cvt_pk_bf16(bb[2], bb[3]); } }
                const size_t off0 = (size_t)EPI_ROW0 * 1024 + (c0 - 8 * fq);
                tr_store(trb, 0, fr, fq, LOGA + off0, 1024, ow_l); tr_store(trb, 1, fr, fq, BB + off0, 1024, ow_b); }
            asm volatile("" ::: "memory"); }
    }
};
struct EpiMerge {
    const bf16* GL; bf16* MERGED;
    __device__ __forceinline__ void mid(f32x4 (&acc)[2][2][4][2], const Unit& u, int wr, int wc, int fr, int fq) const {
        EPI_FOR_ROWS { const size_t row = EPI_ROW;
#pragma unroll
            for (int bj = 0; bj < 2; ++bj) { const int c0 = u.pn * 256 + bj * 128 + wc * 32 + 8 * fq;
                float ga[8], gb[8]; unpack8(*(const u32x4*)(GL + row * 2048 + c0), ga); unpack8(*(const u32x4*)(GL + row * 2048 + 1024 + c0), gb);
#pragma unroll
                for (int e = 0; e < 8; ++e) acc[ai][bj][m][e >> 2][e & 3] *= gb[e] * __builtin_amdgcn_rcpf(fmaxf(ga[e], 1e-12f)); }
            if (m & 1) asm volatile("" ::: "memory"); }
    }
    __device__ __forceinline__ void operator()(const f32x4 (&acc)[2][2][4][2], const Unit& u, int wr, int wc, int fr, int fq, LAS unsigned char* trb) const {
        u32x4 gw[2][4][2];
        EPI_FOR_ROWS { const size_t row = EPI_ROW;
#pragma unroll
            for (int bj = 0; bj < 2; ++bj) gw[ai][m][bj] = *(const u32x4*)(GL + row * 2048 + u.pn * 256 + bj * 128 + wc * 32 + 8 * fq); }
        EPI_FOR_ROWS {
#pragma unroll
            for (int bj = 0; bj < 2; ++bj) { const int c0 = u.pn * 256 + bj * 128 + wc * 32 + 8 * fq; EPI_VALS(bj);
                float ga[8], o[8]; unpack8(gw[ai][m][bj], ga);
#pragma unroll
                for (int e = 0; e < 8; ++e) o[e] = fmaxf(ga[e], 1e-12f) * v[e];
                tr_store(trb, bj, fr, fq, MERGED + (size_t)EPI_ROW0 * 1024 + (c0 - 8 * fq), 1024, pack8(o)); } }
    }
};
struct EpiOut {
    const bf16* H0; bf16* V1;
    __device__ __forceinline__ void operator()(const f32x4 (&acc)[2][2][4][2], const Unit& u, int wr, int wc, int fr, int fq, LAS unsigned char* trb) const {
        u32x4 hw[2][4][2];
        EPI_FOR_ROWS { const size_t row = EPI_ROW;
#pragma unroll
            for (int bj = 0; bj < 2; ++bj) hw[ai][m][bj] = *(const u32x4*)(H0 + row * 1024 + u.pn * 256 + bj * 128 + wc * 32 + 8 * fq); }
        EPI_FOR_ROWS {
#pragma unroll
            for (int bj = 0; bj < 2; ++bj) { const int c0 = u.pn * 256 + bj * 128 + wc * 32 + 8 * fq; EPI_VALS(bj);
                float h[8], o[8]; unpack8(hw[ai][m][bj], h);
#pragma unroll
                for (int e = 0; e < 8; ++e) o[e] = ALPHA * h[e] + v[e];
                tr_store(trb, bj, fr, fq, V1 + (size_t)EPI_ROW0 * 1024 + (c0 - 8 * fq), 1024, pack8(o)); } }
    }
};
struct EpiBf16 {
    bf16* O; int ld;
    __device__ __forceinline__ void operator()(const f32x4 (&acc)[2][2][4][2], const Unit& u, int wr, int wc, int fr, int fq) const {
        EPI_FOR_ROWS { bf16* rowp = O + (size_t)EPI_ROW * ld + u.pn * 256 + wc * 32 + 8 * fq;
#pragma unroll
            for (int bj = 0; bj < 2; ++bj) { EPI_VALS(bj); *(u32x4*)(rowp + bj * 128) = pack8(v); } }
    }
};
}

#define XB_TMO      128
#define XB_XCNT(j)  (256  + 64 * (j))
#define XB_XSUB(j)  (1280 + 64 * (j))
#define XB_XGEN(j)  (2304 + 64 * (j))
#define XB_TOP      3328
#define XB_TOPGEN   3392
#define XCD_BAR_WORDS 3456
#define XB_SPIN_CAP (1u << 18)
__device__ __forceinline__ unsigned xb_ld(unsigned* p)              { return __hip_atomic_load(p, __ATOMIC_RELAXED, __HIP_MEMORY_SCOPE_AGENT); }
__device__ __forceinline__ unsigned xb_add(unsigned* p, unsigned v) { return __hip_atomic_fetch_add(p, v, __ATOMIC_RELAXED, __HIP_MEMORY_SCOPE_AGENT); }
__device__ __forceinline__ unsigned xb_xcc_id() { return (unsigned)__builtin_amdgcn_s_getreg((3 << 11) | 20) & 0xFu; }
#define XB_SPIN(cond, bar) do { unsigned _sp = 0; while (cond) { __builtin_amdgcn_s_sleep(1); \
    if ((++_sp & 255u) == 0u) { if (xb_ld(&(bar)[XB_TMO])) break; if (_sp > XB_SPIN_CAP) { atomicAdd(&(bar)[XB_TMO], 1u); break; } } } } while (0)
struct XcdBarrier { unsigned* bar; unsigned x; volatile LAS unsigned* st; };
__device__ __forceinline__ XcdBarrier xcd_barrier_post(unsigned* bar, volatile LAS unsigned* st) {
    XcdBarrier b; b.bar = bar; b.x = xb_xcc_id(); b.st = st;
    if (threadIdx.x == 0) (void)xb_add(&bar[XB_XCNT(b.x)], 1u);
    return b;
}
__device__ __forceinline__ void xcd_barrier_complete(unsigned* bar, unsigned x, unsigned& nloc, unsigned& nx) {
    const unsigned G = gridDim.x * gridDim.y * gridDim.z;
    unsigned sum, cnt, mine, sp = 0u;
    for (;;) {
        sum = 0u; cnt = 0u; mine = 0u;
#pragma unroll
        for (unsigned j = 0; j < 16; ++j) { const unsigned c = xb_ld(&bar[XB_XCNT(j)]); sum += c; cnt += (c > 0u) ? 1u : 0u; mine = (j == x) ? c : mine; }
        if (sum == G) break;
        __builtin_amdgcn_s_sleep(1);
        if ((++sp & 255u) == 0u) { if (xb_ld(&bar[XB_TMO])) break; if (sp > XB_SPIN_CAP) { atomicAdd(&bar[XB_TMO], 1u); break; } }
    }
    nloc = mine > 0u ? mine : 1u; nx = cnt > 0u ? cnt : 1u;
}
__device__ __forceinline__ void xcd_barrier(const XcdBarrier& b) {
    asm volatile("s_waitcnt vmcnt(0)" ::: "memory");
    __syncthreads();
    if (threadIdx.x == 0) {
        unsigned* bar = b.bar;
        __builtin_amdgcn_s_waitcnt(0);
        unsigned nloc = b.st[0], nx = b.st[1];
        if (nloc == 0u) { xcd_barrier_complete(bar, b.x, nloc, nx); b.st[0] = nloc; b.st[1] = nx; }
        const unsigned old = xb_add(&bar[XB_XSUB(b.x)], 1u);
        const unsigned gen = old / nloc;
        if (old + 1u == (gen + 1u) * nloc) {
            __builtin_amdgcn_fence(__ATOMIC_RELEASE, "agent");
            asm volatile("s_waitcnt vmcnt(0)" ::: "memory");
            const unsigned og = xb_add(&bar[XB_TOP], 1u);
            const unsigned tg = og / nx;
            if (og + 1u == (tg + 1u) * nx) xb_add(&bar[XB_TOPGEN], 1u);
            else XB_SPIN(xb_ld(&bar[XB_TOPGEN]) == tg, bar);
            __builtin_amdgcn_fence(__ATOMIC_ACQUIRE, "agent");
            xb_add(&bar[XB_XGEN(b.x)], 1u);
            asm volatile("s_waitcnt vmcnt(0)" ::: "memory");
        } else {
            XB_SPIN(xb_ld(&bar[XB_XGEN(b.x)]) == gen, bar);
            __builtin_amdgcn_fence(__ATOMIC_ACQUIRE, "agent");
            asm volatile("s_waitcnt vmcnt(0)" ::: "memory");
        }
    }
    __syncthreads();
}

struct Args { const float* in[25]; float* out; unsigned char* ws; int ph_lo, ph_hi; };
enum { I_X = 0, I_META, I_LNIG, I_LNIB, I_WIN, I_CONVW, I_CONVB, I_WRG, I_BRG, I_WIG, I_BIG, I_LRUL, I_WPA, I_POOLW, I_POOLS, I_WPB, I_WOUT, I_LN1G, I_LN1B, I_WQ, I_KEYS, I_EU, I_EV, I_LN2G, I_LN2B };
constexpr int NPHASES = 14;

struct Frame { LAS unsigned char* lds; int tid, lane, wave, G, gw, NGW; };

__device__ __forceinline__ void transpose_item(const float* src, int lds_, bf16* dst, int ldt, LAS float* scr, int lane) {
#pragma unroll 8
    for (int i = 0; i < 32; ++i) { const int kk = 2 * i + (lane >> 5); scr[kk * 33 + (lane & 31)] = src[(size_t)kk * lds_ + (lane & 31)]; }
    LDS_WAIT();
    const int c = lane & 7;
#pragma unroll
    for (int j = 0; j < 4; ++j) { const int n = (lane >> 3) + 8 * j; const LAS float* s = scr + (8 * c) * 33 + n;
        u32x4 o; o.x = cvt_pk_bf16(s[0 * 33], s[1 * 33]); o.y = cvt_pk_bf16(s[2 * 33], s[3 * 33]); o.z = cvt_pk_bf16(s[4 * 33], s[5 * 33]); o.w = cvt_pk_bf16(s[6 * 33], s[7 * 33]);
        *(u32x4*)(dst + (size_t)n * ldt + 8 * c) = o; }
    LDS_WAIT();
}
__device__ __forceinline__ unsigned pack_i8x4(const f32x4 v, float inv) {
    unsigned p = 0u;
    p = __builtin_amdgcn_cvt_pk_u8_f32(__builtin_rintf(v.x * inv) + 128.f, 0u, p); p = __builtin_amdgcn_cvt_pk_u8_f32(__builtin_rintf(v.y * inv) + 128.f, 1u, p);
    p = __builtin_amdgcn_cvt_pk_u8_f32(__builtin_rintf(v.z * inv) + 128.f, 2u, p); p = __builtin_amdgcn_cvt_pk_u8_f32(__builtin_rintf(v.w * inv) + 128.f, 3u, p);
    return p ^ 0x80808080u; }
__device__ __forceinline__ float absmax4(const f32x4 (&v)[4]) { float m = 0.f;
#pragma unroll
    for (int j = 0; j < 4; ++j) m = fmaxf(fmaxf(m, fmaxf(fabsf(v[j].x), fabsf(v[j].y))), fmaxf(fabsf(v[j].z), fabsf(v[j].w)));
    return wave_max(m); }
__device__ __forceinline__ void ln_row(const float* xrow, const float* g, const float* b, int lane, f32x4 (&v)[4]) {
    float s = 0.f;
#pragma unroll
    for (int j = 0; j < 4; ++j) { v[j] = *((const f32x4*)xrow + lane + 64 * j); s += (v[j].x + v[j].y) + (v[j].z + v[j].w); }
    const float mean = wave_sum(s) * (1.f / D); float s2 = 0.f;
#pragma unroll
    for (int j = 0; j < 4; ++j) { v[j] = v[j] - mean; s2 += (v[j].x * v[j].x + v[j].y * v[j].y) + (v[j].z * v[j].z + v[j].w * v[j].w); }
    const float rstd = 1.f / sqrtf(wave_sum(s2) * (1.f / D) + LN_EPS);
#pragma unroll
    for (int j = 0; j < 4; ++j) { const f32x4 gg = *((const f32x4*)g + lane + 64 * j), bb = *((const f32x4*)b + lane + 64 * j); v[j] = v[j] * rstd * gg + bb; }
}
__device__ __forceinline__ void ln_vals(f32x4 (&v)[4], const float* g, const float* b, int lane) {
    float s = 0.f;
#pragma unroll
    for (int j = 0; j < 4; ++j) s += (v[j].x + v[j].y) + (v[j].z + v[j].w);
    const float mean = wave_sum(s) * (1.f / D); float s2 = 0.f;
#pragma unroll
    for (int j = 0; j < 4; ++j) { v[j] = v[j] - mean; s2 += (v[j].x * v[j].x + v[j].y * v[j].y) + (v[j].z * v[j].z + v[j].w * v[j].w); }
    const float rstd = 1.f / sqrtf(wave_sum(s2) * (1.f / D) + LN_EPS);
#pragma unroll
    for (int j = 0; j < 4; ++j) { const f32x4 gg = *((const f32x4*)g + lane + 64 * j), bb = *((const f32x4*)b + lane + 64 * j); v[j] = v[j] * rstd * gg + bb; }
}
__device__ __forceinline__ void ln_row_bf(const bf16* xrow, const float* g, const float* b, int lane, f32x4 (&v)[4]) {
    float s = 0.f;
#pragma unroll
    for (int j = 0; j < 4; ++j) { const u32x2 w = *((const u32x2*)xrow + lane + 64 * j); v[j] = (f32x4){bf_lo(w.x), bf_hi(w.x), bf_lo(w.y), bf_hi(w.y)}; s += (v[j].x + v[j].y) + (v[j].z + v[j].w); }
    const float mean = wave_sum(s) * (1.f / D); float s2 = 0.f;
#pragma unroll
    for (int j = 0; j < 4; ++j) { v[j] = v[j] - mean; s2 += (v[j].x * v[j].x + v[j].y * v[j].y) + (v[j].z * v[j].z + v[j].w * v[j].w); }
    const float rstd = 1.f / sqrtf(wave_sum(s2) * (1.f / D) + LN_EPS);
#pragma unroll
    for (int j = 0; j < 4; ++j) { const f32x4 gg = *((const f32x4*)g + lane + 64 * j), bb = *((const f32x4*)b + lane + 64 * j); v[j] = v[j] * rstd * gg + bb; }
}
__device__ __forceinline__ void store_row_bf16(bf16* orow, int lane, const f32x4 (&v)[4]) {
#pragma unroll
    for (int j = 0; j < 4; ++j) { u32x2 w; w.x = cvt_pk_bf16(v[j].x, v[j].y); w.y = cvt_pk_bf16(v[j].z, v[j].w); *((u32x2*)orow + lane + 64 * j) = w; }
}

__device__ __forceinline__ void p0_prologue(const Frame& F, const Args& a) {
    unsigned char* ws = a.ws;
    if (blockIdx.x < 24) {
        LAS float* hm = (LAS float*)F.lds;
        LAS float* part = (LAS float*)(F.lds + 65536);
        for (int r = F.wave * 2; r < F.wave * 2 + 2; ++r) { f32x4 v[4]; ln_row(a.in[I_META] + (size_t)r * D, a.in[I_LNIG], a.in[I_LNIB], F.lane, v);
#pragma unroll
            for (int j = 0; j < 4; ++j) *((LAS f32x4*)(hm + r * 1024) + F.lane + 64 * j) = v[j]; }
        __syncthreads();
        const int cgp = blockIdx.x; const int col = (cgp < 16 ? cgp * 64 : 2048 + (cgp - 16) * 64) + F.lane;
        float acc[16];
#pragma unroll
        for (int t = 0; t < 16; ++t) acc[t] = 0.f;
        const float* w = a.in[I_WIN];
        for (int k = F.wave * 128; k < F.wave * 128 + 128; k += 4) {
            const float w0 = w[(size_t)(k + 0) * NPROJ + col], w1 = w[(size_t)(k + 1) * NPROJ + col], w2 = w[(size_t)(k + 2) * NPROJ + col], w3 = w[(size_t)(k + 3) * NPROJ + col];
#pragma unroll
            for (int t = 0; t < 16; ++t) { const f32x4 h = *(const LAS f32x4*)(hm + t * 1024 + k); acc[t] += h.x * w0 + h.y * w1 + h.z * w2 + h.w * w3; }
        }
#pragma unroll
        for (int t = 0; t < 16; ++t) part[(F.wave * 16 + t) * 64 + F.lane] = acc[t];
        __syncthreads();
        float* PROJM = (float*)(ws + WS_PROJM);
        for (int idx = F.tid; idx < 16 * 64; idx += NTHREADS) { const int t = idx >> 6, l = idx & 63; float s = 0.f;
#pragma unroll
            for (int w8 = 0; w8 < 8; ++w8) s += part[(w8 * 16 + t) * 64 + l];
            PROJM[t * 1536 + cgp * 64 + l] = s; }
        __syncthreads();
    }
    if (blockIdx.x == F.G - 1) { float* LS8 = (float*)(ws + WS_LS8);
        for (int c = F.tid; c < D; c += NTHREADS) { const float L = a.in[I_LRUL][c]; LS8[c] = 8.f * (fminf(L, 0.f) - log1pf(expf(-fabsf(L)))); } }
    { const float *pw = a.in[I_POOLW], *ps = a.in[I_POOLS], *wpb = a.in[I_WPB]; bf16* BC = (bf16*)(ws + WS_BCAT);
      for (int it = F.gw; it < 128 * 16; it += F.NGW) { const int k0 = (it >> 4) * 4, eb = it & 15, gI = k0 >> 7;
          float pa[4], pb[4], acc[4];
#pragma unroll
          for (int i = 0; i < 4; ++i) { pa[i] = pw[(size_t)(k0 + i) * 128 + F.lane] * ps[gI * 128 + F.lane]; pb[i] = pw[(size_t)(k0 + i) * 128 + 64 + F.lane] * ps[gI * 128 + 64 + F.lane]; acc[i] = 0.f; }
          const float* wcol = wpb + (size_t)(gI * 128) * D + eb * 64 + F.lane;
#pragma unroll 8
          for (int d = 0; d < 64; ++d) { const float w = wcol[(size_t)d * D];
#pragma unroll
              for (int i = 0; i < 4; ++i) acc[i] += __builtin_bit_cast(float, __builtin_amdgcn_readlane(__builtin_bit_cast(int, pa[i]), d)) * w; }
#pragma unroll 8
          for (int d = 0; d < 64; ++d) { const float w = wcol[(size_t)(64 + d) * D];
#pragma unroll
              for (int i = 0; i < 4; ++i) acc[i] += __builtin_bit_cast(float, __builtin_amdgcn_readlane(__builtin_bit_cast(int, pb[i]), d)) * w; }
          u32x2 o; o.x = cvt_pk_bf16(acc[0], acc[1]); o.y = cvt_pk_bf16(acc[2], acc[3]);
          *(u32x2*)(BC + (size_t)(eb * 64 + F.lane) * 1536 + k0) = o; } }
    { LAS float* scr = (LAS float*)(F.lds + F.wave * 16384);
      constexpr int I_IN = 16 * 144, I_PA = 16 * 32, I_OUT = 16 * 32, I_Q = 16 * 64, I_G = 8 * 32;
      constexpr int NIT = I_IN + I_PA + I_OUT + I_Q + I_G;
      for (int it = F.gw; it < NIT; it += F.NGW) { int r = it;
          if (r < I_IN) { const int kb = r / 144, nb = r % 144; transpose_item(a.in[I_WIN] + (size_t)(64 * kb) * NPROJ + 32 * nb, NPROJ, (bf16*)(ws + WS_WINT) + (size_t)(32 * nb) * 1024 + 64 * kb, 1024, scr, F.lane); continue; } r -= I_IN;
          if (r < I_PA) { const int kb = r / 32, nb = r % 32; transpose_item(a.in[I_WPA] + (size_t)(64 * kb) * D + 32 * nb, D, (bf16*)(ws + WS_BCAT) + (size_t)(32 * nb) * 1536 + 512 + 64 * kb, 1536, scr, F.lane); continue; } r -= I_PA;
          if (r < I_OUT) { const int kb = r / 32, nb = r % 32; transpose_item(a.in[I_WOUT] + (size_t)(64 * kb) * D + 32 * nb, D, (bf16*)(ws + WS_WOUTT) + (size_t)(32 * nb) * 1024 + 64 * kb, 1024, scr, F.lane); continue; } r -= I_OUT;
          if (r < I_Q) { const int kb = r / 64, nb = r % 64; transpose_item(a.in[I_WQ] + (size_t)(64 * kb) * 2048 + 32 * nb, 2048, (bf16*)(ws + WS_WQT) + (size_t)(32 * nb) * 1024 + 64 * kb, 1024, scr, F.lane); continue; } r -= I_Q;
          { const int mat = r / 32, rr = r % 32, kb = rr / 8, nb = rr % 8, gate = mat >> 2, n = mat & 3;
            const float* src = a.in[gate ? I_WIG : I_WRG] + (size_t)n * 65536 + (size_t)(64 * kb) * 256 + 32 * nb;
            const int n0 = 32 * nb, drow = (n * 2 + (n0 >> 7)) * 256 + gate * 128 + (n0 & 127);
            transpose_item(src, 256, (bf16*)(ws + WS_GATET) + (size_t)drow * 256 + 64 * kb, 256, scr, F.lane); } } }
    { const float* sk = a.in[I_KEYS]; bf16* kd = (bf16*)(ws + WS_KEYS);
      for (int i = F.gw * 64 + F.lane; i < 8 * 2 * 128 * 128 / 8; i += F.NGW * 64) { const f32x4 x0 = *((const f32x4*)sk + 2 * i), x1 = *((const f32x4*)sk + 2 * i + 1);
          u32x4 o; o.x = cvt_pk_bf16(x0.x, x0.y); o.y = cvt_pk_bf16(x0.z, x0.w); o.z = cvt_pk_bf16(x1.x, x1.y); o.w = cvt_pk_bf16(x1.z, x1.w); *((u32x4*)kd + i) = o; } }
    { bf16* H0 = (bf16*)(ws + WS_H0);
      f32x4 nx[4];
#pragma unroll
      for (int j = 0; j < 4; ++j) nx[j] = *((const f32x4*)(a.in[I_X] + (size_t)(F.gw < M ? F.gw : 0) * D) + F.lane + 64 * j);
#pragma unroll 1
      for (int m = F.gw; m < M; m += F.NGW) { f32x4 v[4]; const int mn = m + F.NGW < M ? m + F.NGW : m;
#pragma unroll
          for (int j = 0; j < 4; ++j) { v[j] = nx[j]; nx[j] = *((const f32x4*)(a.in[I_X] + (size_t)mn * D) + F.lane + 64 * j); }
          ln_vals(v, a.in[I_LNIG], a.in[I_LNIB], F.lane); store_row_bf16(H0 + (size_t)m * D, F.lane, v);
          const float am = fmaxf(absmax4(v), 1e-20f), inv = 127.f / am;
#pragma unroll
          for (int j = 0; j < 4; ++j) *((unsigned*)(ws + WS_H0Q + (size_t)m * D) + F.lane + 64 * j) = pack_i8x4(v[j], inv);
          if (F.lane == 0) ((float*)(ws + WS_SA))[m] = am * (1.f / 127.f); } }
}

__device__ __forceinline__ void p2_convpool(const Frame& F, const Args& a) {
    unsigned char* ws = a.ws; const float* PROJM = (const float*)(ws + WS_PROJM);
    if (blockIdx.x < 4) {
        const int n = blockIdx.x; LAS float* xcm = (LAS float*)F.lds;
        for (int idx = F.tid; idx < 4096; idx += NTHREADS) { const int t = idx >> 8, c = n * 256 + (idx & 255); float v = a.in[I_CONVB][c];
#pragma unroll
            for (int jj = 0; jj < 4; ++jj) { const int tt = t + jj - 3; if (tt >= 0) v += a.in[I_CONVW][jj * D + c] * PROJM[tt * 1536 + c]; }
            xcm[idx] = v; }
        __syncthreads();
        if (F.wave < 4) { const int cl = F.wave * 64 + F.lane, c = n * 256 + cl; float rl[16], il[16];
#pragma unroll
            for (int t = 0; t < 16; ++t) { rl[t] = 0.f; il[t] = 0.f; }
#pragma unroll 8
            for (int k = 0; k < 256; ++k) { const float wr_ = a.in[I_WRG][(size_t)(n * 256 + k) * 256 + cl], wi_ = a.in[I_WIG][(size_t)(n * 256 + k) * 256 + cl];
#pragma unroll
                for (int t = 0; t < 16; ++t) { const float x = xcm[t * 256 + k]; rl[t] += x * wr_; il[t] += x * wi_; } }
            const float brg = a.in[I_BRG][c], big = a.in[I_BIG][c], ls8 = ((const float*)(ws + WS_LS8))[c]; float h = 0.f;
#pragma unroll
            for (int t = 0; t < 16; ++t) { const float r = sigmoidf_(rl[t] + brg), ig = sigmoidf_(il[t] + big); const float l = ls8 * r; const float aa = fast_exp(l);
                const float em = -expm1f(2.f * l); h = aa * h + sqrtf(em) * ig * xcm[t * 256 + cl]; }
            ((float*)(ws + WS_HMETA))[c] = h; }
        __syncthreads();
    }
    { const bf16* XR = (const bf16*)(ws + WS_XR); bf16* XC = (bf16*)(ws + WS_XC); const float *cw = a.in[I_CONVW], *cb = a.in[I_CONVB];
      const int gt = blockIdx.x * NTHREADS + F.tid, GT = F.G * NTHREADS;
      for (int idx = gt; idx < (M / 8) * 128; idx += GT) { const int row0 = (idx >> 7) * 8, c0 = (idx & 127) * 8, t0 = row0 & (SEQ - 1);
          u32x4 xw[11];
          if (t0 >= 8) {
#pragma unroll
              for (int i = 0; i < 11; ++i) xw[i] = *(const u32x4*)(XR + (size_t)(row0 - 3 + i) * D + c0);
          } else {
#pragma unroll
              for (int i = 0; i < 11; ++i) { const int tt = t0 - 3 + i;
                  if (tt >= 0) xw[i] = *(const u32x4*)(XR + (size_t)(row0 - 3 + i) * D + c0);
                  else { float x[8];
#pragma unroll
                      for (int e = 0; e < 8; ++e) x[e] = PROJM[(NMETA + tt) * 1536 + c0 + e];
                      xw[i] = pack8(x); } } }
          float w4[4][8], b8[8];
#pragma unroll
          for (int e = 0; e < 8; ++e) { b8[e] = cb[c0 + e];
#pragma unroll
              for (int jj = 0; jj < 4; ++jj) w4[jj][e] = cw[jj * D + c0 + e]; }
#pragma unroll
          for (int r = 0; r < 8; ++r) { float x0[8], x1[8], x2[8], x3[8], o[8]; unpack8(xw[r], x0); unpack8(xw[r + 1], x1); unpack8(xw[r + 2], x2); unpack8(xw[r + 3], x3);
#pragma unroll
              for (int e = 0; e < 8; ++e) o[e] = b8[e] + w4[0][e] * x0[e] + w4[1][e] * x1[e] + w4[2][e] * x2[e] + w4[3][e] * x3[e];
              *(u32x4*)(XC + (size_t)(row0 + r) * D + c0) = pack8(o); } }
      const bf16* XP = (const bf16*)(ws + WS_XP); bf16* PO = (bf16*)(ws + WS_ACAT);
      for (int idx = gt; idx < (M / 4) * 64; idx += GT) { const int row0 = (idx >> 6) * 4, c0 = (idx & 63) * 8, t0 = row0 & (SEQ - 1), w = 2 << (c0 >> 7);
          float X[19][8];
          if (t0 >= 16) { u32x4 xw[19];
#pragma unroll
              for (int i = 0; i < 19; ++i) xw[i] = (i >= 16 - w) ? *(const u32x4*)(XP + (size_t)(row0 - 15 + i) * DPOOL + c0) : (u32x4){0u, 0u, 0u, 0u};
#pragma unroll
              for (int i = 0; i < 19; ++i) unpack8(xw[i], X[i]);
          } else {
#pragma unroll
              for (int i = 0; i < 19; ++i) { const int tt = t0 - 15 + i;
                  if (tt >= 0) unpack8(*(const u32x4*)(XP + (size_t)(row0 - 15 + i) * DPOOL + c0), X[i]);
                  else {
#pragma unroll
                      for (int e = 0; e < 8; ++e) X[i][e] = PROJM[(NMETA + tt) * 1536 + 1024 + c0 + e]; } } }
          const float inv = 1.f / (float)w;
#pragma unroll
          for (int r = 0; r < 4; ++r) { float s[8];
#pragma unroll
              for (int e = 0; e < 8; ++e) s[e] = 0.f;
#pragma unroll
              for (int j = 0; j < 16; ++j) { const bool on = j < w;
#pragma unroll
                  for (int e = 0; e < 8; ++e) s[e] += on ? X[15 + r - j][e] : 0.f; }
              float o[8];
#pragma unroll
              for (int e = 0; e < 8; ++e) o[e] = s[e] * inv - X[15 + r][e];
              *(u32x4*)(PO + (size_t)(row0 + r) * ACAT_LD + c0) = pack8(o); } } }
}

__device__ __forceinline__ void p4_scan_agg(const Frame& F, const Args& a) {
    unsigned char* ws = a.ws; const bf16* LOGA = (const bf16*)(ws + WS_LOGA); const bf16* BB = (const bf16*)(ws + WS_BB);
    float* AGG = (float*)(ws + WS_AGG); float* SUB = (float*)(ws + WS_SUBAGG);
    LAS float* sh = (LAS float*)F.lds;
    const int s = F.tid >> 7, o = F.tid & 127;
    for (int item = blockIdx.x; item < 256; item += F.G) {
        const size_t row0 = (size_t)item * 256 + s * 64;
        float sl[8], S[8];
#pragma unroll
        for (int e = 0; e < 8; ++e) { sl[e] = 0.f; S[e] = 0.f; }
#pragma unroll 4
        for (int r = 0; r < 64; ++r) { float la[8], bb[8]; unpack8(*(const u32x4*)(LOGA + (row0 + r) * D + o * 8), la); unpack8(*(const u32x4*)(BB + (row0 + r) * D + o * 8), bb);
#pragma unroll
            for (int e = 0; e < 8; ++e) { sl[e] += la[e]; S[e] = fast_exp(la[e]) * S[e] + bb[e]; } }
#pragma unroll
        for (int e = 0; e < 8; ++e) { sh[((s * 1024) + o * 8 + e) * 2] = sl[e]; sh[((s * 1024) + o * 8 + e) * 2 + 1] = S[e];
            SUB[(((size_t)item * 4 + s) * 1024 + o * 8 + e) * 2] = sl[e]; SUB[(((size_t)item * 4 + s) * 1024 + o * 8 + e) * 2 + 1] = S[e]; }
        __syncthreads();
        for (int c = F.tid; c < 1024; c += NTHREADS) { float tl = 0.f, tS = 0.f;
#pragma unroll
            for (int k = 0; k < 4; ++k) { const float l = sh[(k * 1024 + c) * 2], Sk = sh[(k * 1024 + c) * 2 + 1]; tS = fast_exp(l) * tS + Sk; tl += l; }
            AGG[((size_t)item * 1024 + c) * 2] = tl; AGG[((size_t)item * 1024 + c) * 2 + 1] = tS; }
        __syncthreads();
    }
}
__device__ __forceinline__ void p5_scan_apply(const Frame& F, const Args& a) {
    unsigned char* ws = a.ws; const bf16* LOGA = (const bf16*)(ws + WS_LOGA); const bf16* BB = (const bf16*)(ws + WS_BB); bf16* RG = (bf16*)(ws + WS_ACAT) + 512;
    const float* AGG = (const float*)(ws + WS_AGG); const float* SUB = (const float*)(ws + WS_SUBAGG); const float* HMETA = (const float*)(ws + WS_HMETA);
    LAS float* carry = (LAS float*)F.lds;
    const int s = F.tid >> 7, o = F.tid & 127;
    for (int item = blockIdx.x; item < 256; item += F.G) {
        const int b = item >> 5, ch = item & 31;
        for (int c = F.tid; c < 1024; c += NTHREADS) { float h = HMETA[c];
            for (int cc = 0; cc < ch; ++cc) { const float l = AGG[((size_t)(b * 32 + cc) * 1024 + c) * 2], Sk = AGG[((size_t)(b * 32 + cc) * 1024 + c) * 2 + 1]; h = fast_exp(l) * h + Sk; }
            carry[c] = h; }
        __syncthreads();
        float h[8];
#pragma unroll
        for (int e = 0; e < 8; ++e) h[e] = carry[o * 8 + e];
        for (int ss = 0; ss < s; ++ss) {
#pragma unroll
            for (int e = 0; e < 8; ++e) { const float l = SUB[(((size_t)item * 4 + ss) * 1024 + o * 8 + e) * 2], Sk = SUB[(((size_t)item * 4 + ss) * 1024 + o * 8 + e) * 2 + 1]; h[e] = fast_exp(l) * h[e] + Sk; } }
        const size_t row0 = (size_t)item * 256 + s * 64;
#pragma unroll 4
        for (int r = 0; r < 64; ++r) { float la[8], bb[8], gt[8]; const size_t off = (row0 + r) * D + o * 8;
            const size_t offg = (row0 + r) * ACAT_LD + o * 8;
            unpack8(*(const u32x4*)(LOGA + off), la); unpack8(*(const u32x4*)(BB + off), bb); unpack8(*(const u32x4*)(RG + offg), gt); float ov[8];
#pragma unroll
            for (int e = 0; e < 8; ++e) { h[e] = fast_exp(la[e]) * h[e] + bb[e]; ov[e] = h[e] * gelu_tanh(gt[e]); }
            *(u32x4*)(RG + offg) = pack8(ov); }
        __syncthreads();
    }
}

__device__ __forceinline__ void p8_ln1(const Frame& F, const Args& a) {
    unsigned char* ws = a.ws; const bf16* V1 = (const bf16*)(ws + WS_V1); bf16* H1 = (bf16*)(ws + WS_H1);
    unsigned char* H8 = ws + WS_H8; float* SH = (float*)(ws + WS_SH);
    u32x2 nx[4];
#pragma unroll
    for (int j = 0; j < 4; ++j) nx[j] = *((const u32x2*)(V1 + (size_t)(F.gw < M ? F.gw : 0) * D) + F.lane + 64 * j);
#pragma unroll 1
    for (int m = F.gw; m < M; m += F.NGW) { f32x4 v[4]; const int mn = m + F.NGW < M ? m + F.NGW : m;
#pragma unroll
        for (int j = 0; j < 4; ++j) { v[j] = (f32x4){bf_lo(nx[j].x), bf_hi(nx[j].x), bf_lo(nx[j].y), bf_hi(nx[j].y)}; nx[j] = *((const u32x2*)(V1 + (size_t)mn * D) + F.lane + 64 * j); }
        ln_vals(v, a.in[I_LN1G], a.in[I_LN1B], F.lane); store_row_bf16(H1 + (size_t)m * D, F.lane, v);
        const float am = fmaxf(absmax4(v), 1e-20f), inv = 127.f / am;
        u32x4 q; q.x = pack_i8x4(v[0], inv); q.y = pack_i8x4(v[1], inv); q.z = pack_i8x4(v[2], inv); q.w = pack_i8x4(v[3], inv);
        *((u32x4*)(H8 + (size_t)m * D) + F.lane) = q; if (F.lane == 0) SH[m] = am * (1.f / 127.f); }
    { const bf16* WT = (const bf16*)(ws + WS_WQT); unsigned char* WQ8 = ws + WS_WQ8; float* SQ = (float*)(ws + WS_SQ);
      for (int r = F.gw; r < 2048; r += F.NGW) { f32x4 v[4];
#pragma unroll
          for (int j = 0; j < 4; ++j) { const u32x2 w = *((const u32x2*)(WT + (size_t)r * 1024) + F.lane + 64 * j); v[j] = (f32x4){bf_lo(w.x), bf_hi(w.x), bf_lo(w.y), bf_hi(w.y)}; }
          const float am = fmaxf(absmax4(v), 1e-20f), inv = 127.f / am;
          u32x4 q; q.x = pack_i8x4(v[0], inv); q.y = pack_i8x4(v[1], inv); q.z = pack_i8x4(v[2], inv); q.w = pack_i8x4(v[3], inv);
          *((u32x4*)(WQ8 + (size_t)r * 1024) + F.lane) = q; if (F.lane == 0) SQ[r] = am * (1.f / 127.f); } }
}
__device__ __forceinline__ void convert_tables(const Frame& F, const Args& a) {
    unsigned char* ws = a.ws;
    unsigned char* U8 = ws + WS_U8; unsigned char* V8 = ws + WS_V8; unsigned* SUV = (unsigned*)(ws + WS_SU);
    f32x4 un[4], vn[4];
    { const int e0 = F.gw < 16384 ? F.gw : 0;
#pragma unroll
      for (int j = 0; j < 4; ++j) { un[j] = *((const f32x4*)(a.in[I_EU] + (size_t)e0 * D) + F.lane + 64 * j); vn[j] = *((const f32x4*)(a.in[I_EV] + (size_t)e0 * D) + F.lane + 64 * j); } }
#pragma unroll 1
    for (int e = F.gw; e < 16384; e += F.NGW) { f32x4 u[4], v[4];
#pragma unroll
        for (int j = 0; j < 4; ++j) { u[j] = un[j]; v[j] = vn[j]; }
        { const int en = e + F.NGW < 16384 ? e + F.NGW : e;
#pragma unroll
          for (int j = 0; j < 4; ++j) { un[j] = *((const f32x4*)(a.in[I_EU] + (size_t)en * D) + F.lane + 64 * j); vn[j] = *((const f32x4*)(a.in[I_EV] + (size_t)en * D) + F.lane + 64 * j); } }
        const float amu = fmaxf(absmax4(u), 1e-20f), amv = fmaxf(absmax4(v), 1e-20f);
        const unsigned sc = cvt_pk_bf16(amu * (1.f / 127.f) * 1.004f, amv * (1.f / 127.f) * 1.004f);
        const float invu = 1.f / bf_lo(sc), invv = 1.f / bf_hi(sc);
        u32x4 q; q.x = pack_i8x4(u[0], invu); q.y = pack_i8x4(u[1], invu); q.z = pack_i8x4(u[2], invu); q.w = pack_i8x4(u[3], invu);
        *((u32x4*)(U8 + (size_t)e * D) + F.lane) = q;
#pragma unroll
        for (int j = 0; j < 4; ++j) *((unsigned*)(V8 + (size_t)e * D) + F.lane + 64 * j) = pack_i8x4(v[j], invv);
        if (F.lane == 0) SUV[e] = sc; }
}

constexpr int KPITCH = 272;
typedef float f32x16 __attribute__((ext_vector_type(16)));
__device__ __forceinline__ void ce_desc(float& a, float& b) { float hi, lo; asm("v_max_f32 %0, %1, %2" : "=v"(hi) : "v"(a), "v"(b)); asm("v_min_f32 %0, %1, %2" : "=v"(lo) : "v"(a), "v"(b)); a = hi; b = lo; }
__device__ __forceinline__ float max_asm(float a, float b) { float hi; asm("v_max_f32 %0, %1, %2" : "=v"(hi) : "v"(a), "v"(b)); return hi; }
template <int B> __device__ __forceinline__ void sort16_desc(float (&v)[64]) {
#define S16(a, b) ce_desc(v[B + a], v[B + b]);
    S16(0,13) S16(1,12) S16(2,15) S16(3,14) S16(4,8) S16(5,6) S16(7,11) S16(9,10)
    S16(0,5) S16(1,7) S16(2,9) S16(3,4) S16(6,13) S16(8,14) S16(10,15) S16(11,12)
    S16(0,1) S16(2,3) S16(4,5) S16(6,8) S16(7,9) S16(10,11) S16(12,13) S16(14,15)
    S16(0,2) S16(1,3) S16(4,10) S16(5,11) S16(6,7) S16(8,9) S16(12,14) S16(13,15)
    S16(1,2) S16(3,12) S16(4,6) S16(5,7) S16(8,10) S16(9,11) S16(13,14)
    S16(1,4) S16(2,6) S16(5,8) S16(7,10) S16(9,13) S16(11,14)
    S16(2,4) S16(3,6) S16(9,12) S16(11,13)
    S16(3,5) S16(6,8) S16(7,9) S16(10,12)
    S16(3,4) S16(5,6) S16(7,8) S16(9,10) S16(11,12)
    S16(6,7) S16(8,9)
#undef S16
}
template <int B> __device__ __forceinline__ void bitonic_merge16(float (&v)[64]) {
#pragma unroll
    for (int j = 8; j > 0; j >>= 1)
#pragma unroll
        for (int i = 0; i < 16; ++i) { const int l = i ^ j; if (l > i) ce_desc(v[B + i], v[B + l]); }
}
template <int A, int B> __device__ __forceinline__ void merge_top16(float (&v)[64]) {
#pragma unroll
    for (int i = 0; i < 16; ++i) v[A + i] = max_asm(v[A + i], v[B + 15 - i]);
    bitonic_merge16<A>(v);
}
__device__ __forceinline__ void top16_of_64(float (&v)[64]) { sort16_desc<0>(v); sort16_desc<16>(v); sort16_desc<32>(v); sort16_desc<48>(v); merge_top16<0, 16>(v); merge_top16<32, 48>(v); merge_top16<0, 32>(v); }

__device__ __forceinline__ void p10_retrieve(const Frame& F, const Args& a) {
    unsigned char* ws = a.ws; const bf16* Q = (const bf16*)(ws + WS_Q); const bf16* KEYS = (const bf16*)(ws + WS_KEYS);
    unsigned* IDW = (unsigned*)(ws + WS_IDW);
    LAS unsigned char* kl = F.lds;
    const int h = blockIdx.x & 7, rank = blockIdx.x >> 3, nblk = (F.G - h + 7) >> 3;
    for (int pc = F.tid; pc < 2 * 128 * 16; pc += NTHREADS) { const int rowk = pc >> 4, ch = pc & 15;
        *(LAS u32x4*)(kl + rowk * KPITCH + ch * 16) = *((const u32x4*)(KEYS + (size_t)h * 2 * 128 * 128) + pc); }
    __syncthreads();
    if (F.wave < 4) convert_tables(F, a);
    const int tl = F.lane & 31, hh = F.lane >> 5;
    const unsigned hh4 = (unsigned)hh * 4u;
    bf16x8 q0[8], q1[8];
    { const size_t tok0 = (size_t)(rank * NWAVES + F.wave < M / 32 ? rank * NWAVES + F.wave : 0) * 32 + tl;
#pragma unroll
      for (int s = 0; s < 8; ++s) q0[s] = *(const bf16x8*)(Q + tok0 * 2048 + h * 256 + 16 * s + 8 * hh); }
#pragma unroll 1
    for (int grp = rank * NWAVES + F.wave; grp < M / 32; grp += nblk * NWAVES) {
        const size_t tok = (size_t)grp * 32 + tl;
        const int gn = grp + nblk * NWAVES; const size_t tokn = (size_t)(gn < M / 32 ? gn : grp) * 32 + tl;
        float res[2][16];
#pragma unroll
        for (int p = 0; p < 2; ++p) {
            bf16x8 qc[8];
#pragma unroll
            for (int s = 0; s < 8; ++s) qc[s] = p ? q1[s] : q0[s];
            if (p == 0) {
#pragma unroll
                for (int s = 0; s < 8; ++s) q1[s] = *(const bf16x8*)(Q + tok * 2048 + h * 256 + 128 + 16 * s + 8 * hh);
            } else {
#pragma unroll
                for (int s = 0; s < 8; ++s) q0[s] = *(const bf16x8*)(Q + tokn * 2048 + h * 256 + 16 * s + 8 * hh);
            }
            f32x16 acc[4];
#pragma unroll
            for (int kb = 0; kb < 4; ++kb)
#pragma unroll
                for (int r = 0; r < 16; ++r) acc[kb][r] = 0.f;
#pragma unroll
            for (int s = 0; s < 8; ++s)
#pragma unroll
                for (int kb = 0; kb < 4; ++kb) { const bf16x8 kf = *(const LAS bf16x8*)(kl + (p * 128 + kb * 32 + tl) * KPITCH + (16 * s + 8 * hh) * 2);
                    acc[kb] = __builtin_amdgcn_mfma_f32_32x32x16_bf16(kf, qc[s], acc[kb], 0, 0, 0); }
            float v[64];
#pragma unroll
            for (int kb = 0; kb < 4; ++kb)
#pragma unroll
                for (int r = 0; r < 16; ++r) v[kb * 16 + r] = __uint_as_float(((__float_as_uint(acc[kb][r]) & 0xFFFFFF80u) | hh4) | (unsigned)(32 * kb + 8 * (r >> 2) + (r & 3)));
            top16_of_64(v);
#pragma unroll
            for (int i = 0; i < 16; ++i) {
                auto rr = __builtin_amdgcn_permlane32_swap(__float_as_uint(v[15 - i]), __float_as_uint(v[15 - i]), false, false);
                const float partner = __uint_as_float(hh ? rr[0] : rr[1]);
                v[16 + i] = max_asm(v[i], partner); }
            bitonic_merge16<16>(v);
#pragma unroll
            for (int i = 0; i < 16; ++i) res[p][i] = v[16 + i];
            __builtin_amdgcn_sched_barrier(0);
        }
        float v[64]; unsigned i0[16], j1[16];
#pragma unroll
        for (int i = 0; i < 16; ++i) { i0[i] = (__float_as_uint(res[0][i]) & 127u) << 7; j1[i] = __float_as_uint(res[1][i]) & 127u; }
        { int n = 0;
#pragma unroll
          for (int i = 0; i < 16; ++i)
#pragma unroll
              for (int j = 0; j < 16; ++j) if ((i + 1) * (j + 1) <= 16) { v[n] = __uint_as_float((__float_as_uint(res[0][i] + res[1][j]) & 0xFFFFC000u) | i0[i] | j1[j]); ++n; }
#pragma unroll
          for (int q = 50; q < 64; ++q) v[q] = -INFINITY; }
        top16_of_64(v);
        float e[16], sum = 0.f; const float mx = __uint_as_float(__float_as_uint(v[0]) & 0xFFFFC000u);
#pragma unroll
        for (int r = 0; r < 16; ++r) { e[r] = fast_exp(__uint_as_float(__float_as_uint(v[r]) & 0xFFFFC000u) - mx); sum += e[r]; }
        const float inv = 1.f / sum;
        {
            u32x4* o = (u32x4*)(IDW + tok * NSEL + h * 16 + 8 * hh);
#pragma unroll
            for (int q = 0; q < 2; ++q) { u32x4 w4;
#pragma unroll
                for (int c = 0; c < 4; ++c) { const float va = v[4 * q + c], vb = v[8 + 4 * q + c]; const float ea = e[4 * q + c], eb = e[8 + 4 * q + c];
                    const float vv = hh ? vb : va, ee = hh ? eb : ea; w4[c] = ((__float_as_uint(vv) & 0x3FFFu) << 16) | (cvt_pk_bf16(ee * inv, 0.f) & 0xFFFFu); }
                o[q] = w4; } }
    }
    if (F.wave >= 4) convert_tables(F, a);
}

typedef int i32x4 __attribute__((ext_vector_type(4)));
template <int CTRL> __device__ __forceinline__ int dpp_i(int v) { return __builtin_amdgcn_update_dpp(0, v, CTRL, 0xf, 0xf, true); }
struct URaw { unsigned xa, xb; u32x4 h; float sh; int tok; };
struct UMeta8 { int idv, kv, n; float wv, su, sv, sh; u32x4 h; int tok; };
__device__ __forceinline__ void u_prep(URaw& r, int tok, const unsigned* IDW, const unsigned char* H8, const float* SH, int lane) {
    r.tok = tok; const size_t tc = (size_t)(tok < M ? tok : M - 1);
    r.xa = IDW[tc * NSEL + lane]; r.xb = IDW[tc * NSEL + 64 + lane];
    r.h = *((const u32x4*)(H8 + tc * D) + lane); r.sh = SH[tc]; }
__device__ __forceinline__ void u_fetch(UMeta8& m, LAS i32x4* slots, int base, int lane16or32, const LAS unsigned* SUV) {
    const i32x4 e = slots[base + lane16or32]; const bool valid = base + lane16or32 < m.n;
    m.idv = valid ? (int)((unsigned)e.x >> 16) : 0; m.wv = valid ? __uint_as_float((unsigned)e.x << 16) : 0.f; m.kv = e.z; { const unsigned sc = SUV[m.idv & 2047]; m.su = bf_lo(sc); m.sv = bf_hi(sc); } }
__device__ __forceinline__ void u_compact(const URaw& r, UMeta8& m, LAS i32x4* slots, int label, const LAS unsigned* SUV, int lane) {
    const bool ina = (int)(r.xa >> 27) == label, inb = (int)(r.xb >> 27) == label;
    const unsigned long long ma = __ballot(ina), mb = __ballot(inb); const int na = __popcll(ma); m.n = na + __popcll(mb);
    const int ra = __builtin_amdgcn_mbcnt_hi((unsigned)(ma >> 32), __builtin_amdgcn_mbcnt_lo((unsigned)ma, 0)), rb = na + __builtin_amdgcn_mbcnt_hi((unsigned)(mb >> 32), __builtin_amdgcn_mbcnt_lo((unsigned)mb, 0));
    if (ina) slots[ra] = (i32x4){(int)r.xa, 0, lane, 0}; if (inb) slots[rb] = (i32x4){(int)r.xb, 0, 64 + lane, 0};
    m.h = r.h; m.sh = r.sh; m.tok = r.tok;
    u_fetch(m, slots, 0, lane & 31, SUV); }
template <int S0> __device__ __forceinline__ void u_issue16(int idv, int n, u32x4 (&buf)[16], const unsigned char* U8, int lane) {
#pragma unroll
    for (int s = 0; s < 16; ++s) if (S0 + s < n) { const int id = __builtin_amdgcn_readlane(idv, S0 + s); buf[s] = *((const u32x4*)(U8 + (size_t)id * D) + lane); }
}
__device__ __forceinline__ int u_dot16(const u32x4 (&buf)[16], const u32x4 h, int lane) {
    int d[16];
#pragma unroll
    for (int s = 0; s < 16; ++s) { int t = __builtin_amdgcn_sdot4((int)buf[s].x, (int)h.x, 0, false); t = __builtin_amdgcn_sdot4((int)buf[s].y, (int)h.y, t, false);
        t = __builtin_amdgcn_sdot4((int)buf[s].z, (int)h.z, t, false); d[s] = __builtin_amdgcn_sdot4((int)buf[s].w, (int)h.w, t, false); }
    const bool b0 = lane & 1, b1 = lane & 2, b2 = lane & 4, b3 = lane & 8;
    int r1[8], r2[4], r3[2];
#pragma unroll
    for (int p = 0; p < 8; ++p) { const int keep = b0 ? d[2 * p + 1] : d[2 * p], send = b0 ? d[2 * p] : d[2 * p + 1]; r1[p] = keep + dpp_i<0xB1>(send); }
#pragma unroll
    for (int p = 0; p < 4; ++p) { const int keep = b1 ? r1[2 * p + 1] : r1[2 * p], send = b1 ? r1[2 * p] : r1[2 * p + 1]; r2[p] = keep + dpp_i<0x4E>(send); }
#pragma unroll
    for (int p = 0; p < 2; ++p) { const int keep = b2 ? r2[2 * p + 1] : r2[2 * p], send = b2 ? r2[2 * p] : r2[2 * p + 1]; r3[p] = keep + __builtin_amdgcn_ds_swizzle(send, 0x101F); }
    int r4; { const int keep = b3 ? r3[1] : r3[0], send = b3 ? r3[0] : r3[1]; r4 = keep + dpp_i<0x128>(send); }
    { auto q = __builtin_amdgcn_permlane16_swap((unsigned)r4, (unsigned)r4, false, false); r4 = (int)q[0] + (int)q[1]; }
    { auto q = __builtin_amdgcn_permlane32_swap((unsigned)r4, (unsigned)r4, false, false); r4 = (int)q[0] + (int)q[1]; }
    return r4; }
__device__ __forceinline__ float u_z(const UMeta8& m, int d) { return gelu_tanh((float)d * m.su * m.sh) * m.wv * m.sv; }
__device__ __forceinline__ void p11_expert_u(const Frame& F, const Args& a) {
    unsigned char* ws = a.ws; const unsigned* IDW = (const unsigned*)(ws + WS_IDW);
    const unsigned char* U8 = ws + WS_U8; const unsigned char* H8 = ws + WS_H8; const unsigned* SUVg = (const unsigned*)(ws + WS_SU); const float* SH = (const float*)(ws + WS_SH);
    unsigned* ZI = (unsigned*)(ws + WS_ZI);
    const int label = blockIdx.x & 7, rank = blockIdx.x >> 3, nblk = (F.G - label + 7) >> 3, widx = rank * NWAVES + F.wave, wstride = nblk * NWAVES;
    const int T = (M - widx + wstride - 1) / wstride;
    LAS i32x4* slot0 = (LAS i32x4*)(F.lds + F.wave * 4096);
    LAS unsigned* SUV = (LAS unsigned*)(F.lds + 32768);
    for (int i = F.tid; i < 2048; i += NTHREADS) SUV[i] = SUVg[label * 2048 + i];
    __syncthreads();
#define U_TOK(q) ((q) < T ? widx + (q) * wstride : M)
    URaw rw; UMeta8 mc, mn; u32x4 bA[16], bB[16];
#pragma unroll
    for (int s = 0; s < 16; ++s) { bA[s] = (u32x4){0u, 0u, 0u, 0u}; bB[s] = bA[s]; }
    u_prep(rw, U_TOK(0), IDW, H8, SH, F.lane);
    u_compact(rw, mc, slot0, label, SUV, F.lane);
    u_prep(rw, U_TOK(1), IDW, H8, SH, F.lane);
    u_issue16<0>(mc.idv, mc.n, bA, U8, F.lane); u_issue16<16>(mc.idv, mc.n, bB, U8, F.lane);
#pragma unroll 1
    for (int q = 0; q < T; ++q) {
        LAS i32x4* scur = slot0 + (q & 1) * 128; LAS i32x4* snxt = slot0 + ((q + 1) & 1) * 128;
        u_compact(rw, mn, snxt, label, SUV, F.lane);
        u_prep(rw, U_TOK(q + 2), IDW, H8, SH, F.lane);
        const int dA = u_dot16(bA, mc.h, F.lane);
        u_issue16<0>(mn.idv, mn.n, bA, U8, F.lane);
        int dB = 0; if (mc.n > 16) dB = u_dot16(bB, mc.h, F.lane);
        u_issue16<16>(mn.idv, mn.n, bB, U8, F.lane);
        { const float z = u_z(mc, (F.lane & 16) ? dB : dA); if (mc.tok < M && F.lane < (mc.n < 32 ? mc.n : 32)) ZI[(size_t)mc.tok * NSEL + mc.kv] = ((unsigned)mc.idv << 16) | (cvt_pk_bf16(z, 0.f) & 0xFFFFu); }
#pragma unroll 1
        for (int base = 32; base < mc.n; base += 16) {
            UMeta8 mo = mc; u_fetch(mo, scur, base, F.lane & 15, SUV); u32x4 bx[16]; u_issue16<0>(mo.idv, 16, bx, U8, F.lane);
            const int dx = u_dot16(bx, mc.h, F.lane); const float z = u_z(mo, dx);
            if (mc.tok < M && F.lane < 16 && base + F.lane < mc.n) ZI[(size_t)mc.tok * NSEL + mo.kv] = ((unsigned)mo.idv << 16) | (cvt_pk_bf16(z, 0.f) & 0xFFFFu); }
        mc = mn;
    }
#undef U_TOK
}
struct VMeta { unsigned xa, xb; int tok; };
struct VBatch { u32x4 pc[16]; };
__device__ __forceinline__ void v_load_meta(VMeta& m, int tok, const unsigned* ZI, int lane) {
    m.tok = tok; const size_t tc = (size_t)(tok < M ? tok : M - 1);
    m.xa = ZI[tc * NSEL + lane]; m.xb = ZI[tc * NSEL + 64 + lane]; }
__device__ __forceinline__ void v_issue(const VMeta& m, int cs, VBatch& b, const unsigned char* V8, int sub, int grp) {
#pragma unroll
    for (int i = 0; i < 16; ++i) { const int src = (8 * i + grp) & 63; const int id = (int)(((i < 8) ? (unsigned)__shfl((int)m.xa, src) : (unsigned)__shfl((int)m.xb, src)) >> 16);
        b.pc[i] = *(const u32x4*)(V8 + (size_t)id * D + cs * 128 + sub * 16); }
}
__device__ __forceinline__ void v_compute(const VMeta& m, int cs, const VBatch& b, bf16* out, int sub, int grp, int lane) {
    const float za = __uint_as_float(m.xa << 16), zb = __uint_as_float(m.xb << 16);
    const float cmax = wave_max(fmaxf(fabsf(za), fabsf(zb))); const float inv = cmax > 0.f ? 127.f / cmax : 0.f, sct = cmax * (1.f / 127.f);
    const int cqa = (int)__builtin_rintf(za * inv) & 255, cqb = (int)__builtin_rintf(zb * inv) & 255;
    int acc[16];
#pragma unroll
    for (int e = 0; e < 16; ++e) acc[e] = 0;
#pragma unroll
    for (int a4 = 0; a4 < 4; ++a4) {
        unsigned C = 0u;
#pragma unroll
        for (int j = 0; j < 4; ++j) { const int src = (32 * a4 + 8 * j + grp) & 63; const unsigned g = (unsigned)((a4 < 2) ? __shfl(cqa, src) : __shfl(cqb, src)); C |= g << (8 * j); }
#pragma unroll
        for (int d = 0; d < 4; ++d) { const unsigned W0 = b.pc[4 * a4][d], W1 = b.pc[4 * a4 + 1][d], W2 = b.pc[4 * a4 + 2][d], W3 = b.pc[4 * a4 + 3][d];
            const unsigned P01l = __builtin_amdgcn_perm(W1, W0, 0x05010400u), P01h = __builtin_amdgcn_perm(W1, W0, 0x07030602u);
            const unsigned P23l = __builtin_amdgcn_perm(W3, W2, 0x05010400u), P23h = __builtin_amdgcn_perm(W3, W2, 0x07030602u);
            const unsigned T0 = __builtin_amdgcn_perm(P23l, P01l, 0x05040100u), T1 = __builtin_amdgcn_perm(P23l, P01l, 0x07060302u);
            const unsigned T2 = __builtin_amdgcn_perm(P23h, P01h, 0x05040100u), T3 = __builtin_amdgcn_perm(P23h, P01h, 0x07060302u);
            acc[4 * d] = __builtin_amdgcn_sdot4((int)T0, (int)C, acc[4 * d], false); acc[4 * d + 1] = __builtin_amdgcn_sdot4((int)T1, (int)C, acc[4 * d + 1], false);
            acc[4 * d + 2] = __builtin_amdgcn_sdot4((int)T2, (int)C, acc[4 * d + 2], false); acc[4 * d + 3] = __builtin_amdgcn_sdot4((int)T3, (int)C, acc[4 * d + 3], false); } }
    const bool b3 = grp & 1;
#define V_L1(lo, hi) ((b3 ? acc[hi] : acc[lo]) + dpp_i<0x128>(b3 ? acc[lo] : acc[hi]))
    const int r1_0 = V_L1(0, 2), r1_1 = V_L1(1, 3), r1_2 = V_L1(4, 6), r1_3 = V_L1(5, 7), r1_4 = V_L1(8, 10), r1_5 = V_L1(9, 11), r1_6 = V_L1(12, 14), r1_7 = V_L1(13, 15);
#undef V_L1
#define V_SW16(x, y, o) int o; { auto q = __builtin_amdgcn_permlane16_swap((unsigned)(x), (unsigned)(y), false, false); o = (int)q[0] + (int)q[1]; }
#define V_SW32(x, y, o) int o; { auto q = __builtin_amdgcn_permlane32_swap((unsigned)(x), (unsigned)(y), false, false); o = (int)q[0] + (int)q[1]; }
    V_SW16(r1_0, r1_2, r2_0) V_SW16(r1_1, r1_3, r2_1) V_SW16(r1_4, r1_6, r2_2) V_SW16(r1_5, r1_7, r2_3)
    V_SW32(r2_0, r2_2, r3_0) V_SW32(r2_1, r2_3, r3_1)
#undef V_SW16
#undef V_SW32
    if (m.tok < M) *(unsigned*)(out + (size_t)m.tok * D + cs * 128 + sub * 16 + 2 * grp) = cvt_pk_bf16((float)r3_0 * sct, (float)r3_1 * sct);
}
__device__ __forceinline__ void p12_expert_v(const Frame& F, const Args& a) {
    unsigned char* ws = a.ws; const unsigned* ZI = (const unsigned*)(ws + WS_ZI); const unsigned char* V8 = ws + WS_V8;
    const int label = blockIdx.x & 7, rank = blockIdx.x >> 3, nblk = (F.G - label + 7) >> 3, widx = rank * NWAVES + F.wave, wstride = nblk * NWAVES;
    const int sub = F.lane & 7, grp = F.lane >> 3;
    const int T = (M - widx + wstride - 1) / wstride, NQ = (T + 1) & ~1;
#define V_TOK(q) ((q) < T ? widx + (q) * wstride : M)
    VMeta mc, mn, mf; VBatch bA, bB;
    v_load_meta(mc, V_TOK(0), ZI, F.lane); v_load_meta(mn, V_TOK(1), ZI, F.lane);
    v_issue(mc, label, bA, V8, sub, grp);
#pragma unroll 1
    for (int q = 0; q < NQ; q += 2) {
        v_issue(mn, label, bB, V8, sub, grp); v_load_meta(mf, V_TOK(q + 2), ZI, F.lane); v_compute(mc, label, bA, (bf16*)(a.ws + WS_FFN), sub, grp, F.lane); mc = mn; mn = mf;
        v_issue(mn, label, bA, V8, sub, grp); v_load_meta(mf, V_TOK(q + 3), ZI, F.lane); v_compute(mc, label, bB, (bf16*)(a.ws + WS_FFN), sub, grp, F.lane); mc = mn; mn = mf;
    }
#undef V_TOK
}
__device__ __forceinline__ void p13_final(const Frame& F, const Args& a) {
    const bf16* H1 = (const bf16*)(a.ws + WS_H1); const bf16* FFN = (const bf16*)(a.ws + WS_FFN);
    u32x2 nh[4], nf[4];
#pragma unroll
    for (int j = 0; j < 4; ++j) { const size_t t0 = (size_t)(F.gw < M ? F.gw : 0); nh[j] = *((const u32x2*)(H1 + t0 * D) + F.lane + 64 * j); nf[j] = *((const u32x2*)(FFN + t0 * D) + F.lane + 64 * j); }
#pragma unroll 1
    for (int tok = F.gw; tok < M; tok += F.NGW) {
        f32x4 y[4]; const size_t tn = (size_t)(tok + F.NGW < M ? tok + F.NGW : tok);
#pragma unroll
        for (int j = 0; j < 4; ++j) { const u32x2 w = nh[j], f = nf[j];
            y[j].x = ALPHA * bf_lo(w.x) + bf_lo(f.x); y[j].y = ALPHA * bf_hi(w.x) + bf_hi(f.x); y[j].z = ALPHA * bf_lo(w.y) + bf_lo(f.y); y[j].w = ALPHA * bf_hi(w.y) + bf_hi(f.y);
            nh[j] = *((const u32x2*)(H1 + tn * D) + F.lane + 64 * j); nf[j] = *((const u32x2*)(FFN + tn * D) + F.lane + 64 * j); }
        ln_vals(y, a.in[I_LN2G], a.in[I_LN2B], F.lane);
#pragma unroll
        for (int j = 0; j < 4; ++j) *((f32x4*)(a.out + (size_t)tok * D) + F.lane + 64 * j) = y[j];
    }
}

__device__ __forceinline__ void g1a_inproj(const Frame& F, const Args& a) { unsigned char* ws = a.ws;
    const bf16* WT = (const bf16*)(ws + WS_WINT); unsigned char* WG8 = ws + WS_WG8; float* SB = (float*)(ws + WS_SB);
    for (int r = F.gw; r < NPROJ; r += F.NGW) { f32x4 v[4];
#pragma unroll
        for (int j = 0; j < 4; ++j) { const u32x2 w = *((const u32x2*)(WT + (size_t)r * 1024) + F.lane + 64 * j); v[j] = (f32x4){bf_lo(w.x), bf_hi(w.x), bf_lo(w.y), bf_hi(w.y)}; }
        const float am = fmaxf(absmax4(v), 1e-20f), inv = 127.f / am;
#pragma unroll
        for (int j = 0; j < 4; ++j) *((unsigned*)(WG8 + (size_t)r * 1024) + F.lane + 64 * j) = pack_i8x4(v[j], inv);
        if (F.lane == 0) SB[r] = am * (1.f / 127.f); } }
__device__ __forceinline__ void g1b_inproj(const Frame& F, const Args& a) { unsigned char* ws = a.ws; pg8::StaticOrder S;
    pg8::Gemm g{(const char*)(ws + WS_H0Q), (const char*)(ws + WS_WG8), 512u, 512u, 8, 256, 18, -1}; S.init(256, 18, F.G, blockIdx.x);
    pg8::EpiInProjSig8 E{(bf16*)(ws + WS_XR), (bf16*)(ws + WS_ACAT), (bf16*)(ws + WS_XP), (bf16*)(ws + WS_GL), (const float*)(ws + WS_SA), (const float*)(ws + WS_SB)};
    pg8::gemm_phase<pg8::EpiInProjSig8, true, true, -1, true>(F.lds, g, S, E); }
__device__ __forceinline__ void g3_gate(const Frame& F, const Args& a) { unsigned char* ws = a.ws; pg8::StaticOrder S;
    pg8::Gemm g{(const char*)(ws + WS_XC), (const char*)(ws + WS_GATET), 1024u, 256u, 4, 256, 8, 1}; S.init(256, 8, F.G, blockIdx.x);
    pg8::EpiGate E{(const bf16*)(ws + WS_XC), a.in[I_BRG], a.in[I_BIG], (const float*)(ws + WS_LS8), (bf16*)(ws + WS_LOGA), (bf16*)(ws + WS_BB)};
    pg8::gemm_phase<pg8::EpiGate, true, true>(F.lds, g, S, E); }
__device__ __forceinline__ void g6_merge(const Frame& F, const Args& a) { unsigned char* ws = a.ws; pg8::StaticOrder S; S.init(256, 4, F.G, blockIdx.x);
    pg8::Gemm g{(const char*)(ws + WS_ACAT), (const char*)(ws + WS_BCAT), 1536u, 1536u, 24, 256, 4, -1};
    pg8::EpiMerge E{(const bf16*)(ws + WS_GL), (bf16*)(ws + WS_MERGED)};
    pg8::gemm_phase<pg8::EpiMerge, true, true, 8>(F.lds, g, S, E); }
__device__ __forceinline__ void g7_out(const Frame& F, const Args& a) { unsigned char* ws = a.ws; pg8::StaticOrder S;
    pg8::Gemm g{(const char*)(ws + WS_MERGED), (const char*)(ws + WS_WOUTT), 1024u, 1024u, 16, 256, 4, -1}; S.init(256, 4, F.G, blockIdx.x);
    pg8::EpiOut E{(const bf16*)(ws + WS_H0), (bf16*)(ws + WS_V1)};
    pg8::gemm_phase<pg8::EpiOut, true, true>(F.lds, g, S, E); }
__device__ __forceinline__ void g9_q(const Frame& F, const Args& a) { unsigned char* ws = a.ws; pg8::StaticOrder S;
    pg8::Gemm g{(const char*)(ws + WS_H8), (const char*)(ws + WS_WQ8), 512u, 512u, 8, 256, 8, -1}; S.init(256, 8, F.G, blockIdx.x);
    pg8::EpiQ8 E{(bf16*)(ws + WS_Q), (const float*)(ws + WS_SH), (const float*)(ws + WS_SQ)};
    pg8::gemm_phase<pg8::EpiQ8, true, true, -1, true>(F.lds, g, S, E); }

__global__ void __launch_bounds__(NTHREADS, 2) fwd_kernel(Args a) {
    extern __shared__ __attribute__((aligned(16))) unsigned char lds_raw[];
    Frame F; F.lds = (LAS unsigned char*)lds_raw; F.tid = threadIdx.x; F.lane = F.tid & 63; F.wave = __builtin_amdgcn_readfirstlane(F.tid >> 6); F.G = gridDim.x;
    F.gw = blockIdx.x * NWAVES + F.wave; F.NGW = F.G * NWAVES;
    unsigned char* ws = a.ws;
    const int lo = a.ph_lo, hi = a.ph_hi;
    volatile LAS unsigned* misc = (volatile LAS unsigned*)(F.lds + 131072);
    if (F.tid < 4) misc[F.tid] = 0u;
    __syncthreads();
    if (a.ph_lo < 0) cg::this_grid().sync();
    XcdBarrier xbar = xcd_barrier_post((unsigned*)(ws + WS_CTL) + 4096, misc);
#ifndef REP_MASK
#define REP_MASK 0
#endif
#define IN(k) (lo <= (k) && (k) < hi)
#define REP(k) ((REP_MASK >> (k)) & 1)
#define SEAM(k) do { if (IN(k) && IN((k) + 1)) { xcd_barrier(xbar); } } while (0)
    if (IN(0)) { p0_prologue(F, a); if (REP(0)) p0_prologue(F, a); } SEAM(0);
    if (IN(1)) { g1a_inproj(F, a); xcd_barrier(xbar); g1b_inproj(F, a); } SEAM(1);
    if (IN(2)) { p2_convpool(F, a); if (REP(2)) p2_convpool(F, a); } SEAM(2);
    if (IN(3)) { g3_gate(F, a); if (REP(3)) g3_gate(F, a); } SEAM(3);
    if (IN(4)) { p4_scan_agg(F, a); if (REP(4)) p4_scan_agg(F, a); } SEAM(4);
    if (IN(5)) { p5_scan_apply(F, a); if (REP(5)) p5_scan_apply(F, a); } SEAM(5);
    if (IN(6)) { g6_merge(F, a); if (REP(6)) g6_merge(F, a); } SEAM(6);
    if (IN(7)) { g7_out(F, a); if (REP(7)) g7_out(F, a); } SEAM(7);
    if (IN(8)) { p8_ln1(F, a); if (REP(8)) p8_ln1(F, a); } SEAM(8);
    if (IN(9)) { g9_q(F, a); if (REP(9)) g9_q(F, a); } SEAM(9);
    if (IN(10)) { p10_retrieve(F, a); if (REP(10)) p10_retrieve(F, a); } SEAM(10);
    if (IN(11)) { p11_expert_u(F, a); if (REP(11)) p11_expert_u(F, a); } SEAM(11);
    if (IN(12)) { p12_expert_v(F, a); if (REP(12)) p12_expert_v(F, a); } SEAM(12);
    if (IN(13)) { p13_final(F, a); }
#undef IN
#undef SEAM
}

extern "C" void kernel_launch(void* const* d_in, const int* in_sizes, int n_in, void* d_out, int out_size, void* d_ws, size_t ws_size, hipStream_t stream) {
    static int grid = 0;
    if (grid == 0) {
        if (n_in != 25 || in_sizes[0] != M * D || out_size != M * D || ws_size < WS_END) { fprintf(stderr, "kernel_launch: unexpected shapes: n_in %d in0 %d out %d ws %zu\n", n_in, n_in > 0 ? in_sizes[0] : -1, out_size, ws_size); grid = -1; return; }
        int dev = 0, cus = 0, per_cu = 0;
        hipGetDevice(&dev); hipDeviceGetAttribute(&cus, hipDeviceAttributeMultiprocessorCount, dev);
        if (hipFuncSetAttribute((const void*)fwd_kernel, hipFuncAttributeMaxDynamicSharedMemorySize, LDS_BYTES) != hipSuccess) { fprintf(stderr, "kernel_launch: hipFuncSetAttribute failed\n"); grid = -1; return; }
        if (hipOccupancyMaxActiveBlocksPerMultiprocessor(&per_cu, (const void*)fwd_kernel, NTHREADS, LDS_BYTES) != hipSuccess || per_cu < 1) { fprintf(stderr, "kernel_launch: occupancy query says %d\n", per_cu); per_cu = 1; }
        (void)hipGetLastError();
        grid = cus;
        fprintf(stderr, "kernel_launch: grid %d (occupancy query %d per CU)\n", grid, per_cu);
    }
    if (grid < 0) return;
    if (hipMemsetAsync((char*)d_ws + WS_CTL, 0, 65536, stream) != hipSuccess) { fprintf(stderr, "kernel_launch: hipMemsetAsync failed\n"); return; }
    Args a{};
    for (int i = 0; i < 25; ++i) a.in[i] = (const float*)d_in[i];
    a.out = (float*)d_out; a.ws = (unsigned char*)d_ws;
#if MK_ONE_LAUNCH
    a.ph_lo = 0; a.ph_hi = NPHASES;
    { void* args[] = {&a}; hipError_t e = hipLaunchCooperativeKernel((const void*)fwd_kernel, dim3(grid), dim3(NTHREADS), args, LDS_BYTES, stream);
      if (e != hipSuccess) fprintf(stderr, "kernel_launch: cooperative launch failed: %s\n", hipGetErrorString(e)); }
#else
    for (int p = 0; p < NPHASES; ++p) { a.ph_lo = p; a.ph_hi = p + 1; void* args[] = {&a};
        hipError_t e = hipLaunchCooperativeKernel((const void*)fwd_kernel, dim3(grid), dim3(NTHREADS), args, LDS_BYTES, stream);
        if (e != hipSuccess) { fprintf(stderr, "kernel_launch: launch %d failed: %s\n", p, hipGetErrorString(e)); break; } }
#endif
}
```
